# Optimizing an MI355X kernel written in HIP

```python
import math
import jax
import jax.numpy as jnp
from jax import lax
import numpy as np

D_MODEL = 2048
BATCH = 2
SEQ = 4096
DEPTH = 4

GRID_W = 64
CTX_LEN = 256
N_MIXERS = 3
EPS = 1e-6
D_FF = ((8 * D_MODEL // 3 + 255) // 256) * 256

S5_GROUP = 16
S5_STATE = 64
S5_GROUPS = D_MODEL // S5_GROUP

HY_ORDER = 2
HY_CONV_W = 3
HY_BANDS = 16
HY_EMB = 1 + 2 * HY_BANDS
HY_FILTER_HIDDEN = 64
HY_DECAY_TARGET = 1e-2
HY_FAST_DECAY_PCT = 0.3
HY_SLOW_DECAY_PCT = 1.5
HY_MAX_DECAY = math.log(HY_DECAY_TARGET) / HY_FAST_DECAY_PCT
HY_MIN_DECAY = math.log(HY_DECAY_TARGET) / HY_SLOW_DECAY_PCT

GDN_K_HEADS = 16
GDN_V_HEADS = 32
GDN_HEAD_K = D_MODEL // GDN_K_HEADS
GDN_HEAD_V = 128
GDN_QK = GDN_K_HEADS * GDN_HEAD_K
GDN_V = GDN_V_HEADS * GDN_HEAD_V
GDN_CONV_DIM = 2 * GDN_QK + GDN_V
GDN_PROJ = GDN_CONV_DIM + GDN_V + 4 * GDN_V_HEADS
GDN_CONV_W = 5
GDN_CHUNK = 64

N_S5 = (DEPTH + 2) // 3
N_HY = (DEPTH + 1) // 3
N_GDN = DEPTH // 3

kernel_name = 'hybrid_s5_hyena_gdn_prefix_dit'

F32 = jnp.float32


def _rmsnorm(x, g):
    xf = x.astype(F32)
    y = xf * lax.rsqrt(jnp.mean(xf * xf, axis=-1, keepdims=True) + EPS)
    return (y * g.astype(F32)).astype(x.dtype)


def _l2norm(x):
    return x * lax.rsqrt(jnp.sum(x * x, axis=-1, keepdims=True) + 1e-6)


def _flip_time(t, rev):
    return jnp.flip(t, axis=1) if rev else t


def _grid_order(x, col_major):
    if not col_major:
        return x
    b, n, d = x.shape
    rows = n // GRID_W
    return x.reshape(b, rows, GRID_W, d).transpose(0, 2, 1, 3).reshape(b, n, d)


def _grid_unorder(x, col_major):
    if not col_major:
        return x
    b, n, d = x.shape
    rows = n // GRID_W
    return x.reshape(b, GRID_W, rows, d).transpose(0, 2, 1, 3).reshape(b, n, d)


def _dwconv(x, w):
    k_w = w.shape[0]
    n = x.shape[1]
    p = k_w // 2
    xp = jnp.pad(x, ((0, 0), (p, p), (0, 0)))
    y = xp[:, 0:n] * w[0]
    for t in range(1, k_w):
        y = y + xp[:, t:t + n] * w[t]
    return y


def _swiglu(h, wg, wu, wd):
    return (jax.nn.silu(h @ wg) * (h @ wu)) @ wd


def _s5_discretise(a_re, a_im, log_dt, b_re, b_im):
    lam = lax.complex(a_re.astype(F32), a_im.astype(F32))
    dt = jnp.exp(log_dt.astype(F32))[:, None]
    lam_bar = jnp.exp(lam * dt)
    b = lax.complex(b_re.astype(F32), b_im.astype(F32))
    b_bar = ((lam_bar - 1.0) / lam)[..., None] * b
    return lam_bar, b_bar


def _s5_scan(u, lam_bar, b_bar, h0):
    bu = jnp.einsum('blgc,gpc->lbgp', u.astype(jnp.complex64), b_bar)
    a = jnp.broadcast_to(lam_bar[None, None], (u.shape[1], 1) + lam_bar.shape)

    def combine(e1, e2):
        a1, b1 = e1
        a2, b2 = e2
        return a2 * a1, a2 * b1 + b2

    a_cum, hs = lax.associative_scan(combine, (a, bu), axis=0)
    hs = hs + a_cum * h0[None]
    return hs, hs[-1]


def _s5_readout(hs, cmat):
    y = jnp.einsum('lbgp,gcp->blgc', hs, cmat).real
    return y.reshape(y.shape[0], y.shape[1], -1)


def _s5_mixer(h_ctx, h_lat, a_re, a_im, log_dt, b_re, b_im, c_re, c_im, d, glu_w, glu_b):
    def groups(t):
        return t.astype(F32).reshape(t.shape[0], t.shape[1], S5_GROUPS, S5_GROUP)

    u_ctx, u_lat = groups(h_ctx), groups(h_lat)
    y_ctx = h_ctx.astype(F32) * d.astype(F32)
    y_lat = h_lat.astype(F32) * d.astype(F32)
    h0 = jnp.zeros((h_lat.shape[0], S5_GROUPS, S5_STATE), jnp.complex64)
    for direction in range(2):
        rev = direction == 1
        lam_bar, b_bar = _s5_discretise(a_re[direction], a_im[direction], log_dt[direction],
                                        b_re[direction], b_im[direction])
        cmat = lax.complex(c_re[direction].astype(F32), c_im[direction].astype(F32))
        hs_ctx, h_ctx_last = _s5_scan(_flip_time(u_ctx, rev), lam_bar, b_bar, h0)
        hs_lat, _ = _s5_scan(_flip_time(u_lat, rev), lam_bar, b_bar, h_ctx_last)
        y_ctx = y_ctx + _flip_time(_s5_readout(hs_ctx, cmat), rev)
        y_lat = y_lat + _flip_time(_s5_readout(hs_lat, cmat), rev)

    def glu(y):
        z = jax.nn.gelu(y)
        gz = z @ glu_w.astype(F32) + glu_b.astype(F32)
        return gz[..., :D_MODEL] * jax.nn.sigmoid(gz[..., D_MODEL:])

    return glu(y_ctx).astype(h_ctx.dtype), glu(y_lat).astype(h_lat.dtype)


def _hyena_filters(n, w1, b1, w2, b2, w3, b3, w4, freq):
    t = jnp.arange(n, dtype=F32)
    t_unit = t / max(n - 1, 1)
    bands = jnp.linspace(1e-4, HY_BANDS - 1, HY_BANDS, dtype=F32)
    ang = (2.0 * math.pi / n) * t[:, None] * bands[None, :]
    feats = jnp.concatenate([t_unit[:, None], jnp.cos(ang), -jnp.sin(ang)], axis=-1)
    fq = freq.astype(F32)
    hdn = jnp.sin(fq * (feats @ w1.astype(F32) + b1.astype(F32)))
    hdn = jnp.sin(fq * (hdn @ w2.astype(F32) + b2.astype(F32)))
    hdn = jnp.sin(fq * (hdn @ w3.astype(F32) + b3.astype(F32)))
    filt = (hdn @ w4.astype(F32)).reshape(n, HY_ORDER, 2, D_MODEL)
    deltas = jnp.abs(jnp.linspace(HY_MIN_DECAY, HY_MAX_DECAY, D_MODEL, dtype=F32))
    filt = filt * jnp.exp(-t_unit[:, None] * deltas[None, :])[:, None, None, :]
    two_sided = jnp.concatenate([filt[:, :, 0],
                                 jnp.zeros((1, HY_ORDER, D_MODEL), F32),
                                 jnp.flip(filt[1:, :, 1], axis=0)], axis=0)
    two_sided = two_sided / jnp.sum(jnp.abs(two_sided), axis=0, keepdims=True)
    return jnp.fft.rfft(two_sided, axis=0)


def _fft_conv(z, hf, bias):
    n = z.shape[1]
    zf = jnp.fft.rfft(z, n=2 * n, axis=1)
    y = jnp.fft.irfft(zf * hf[None], n=2 * n, axis=1)[:, :n]
    return y + z * bias.astype(F32)


def _hyena_mixer(h_ctx, h_lat, in_w, in_b, conv_w, conv_b, f_w1, f_b1, f_w2, f_b2, f_w3, f_b3,
                 f_w4, f_freq, bias, out_w, out_b):
    def one_sequence(h):
        n = h.shape[1]
        u = (h @ in_w + in_b).astype(F32)
        u = _dwconv(u, conv_w.astype(F32)) + conv_b.astype(F32)
        v, x1, x2 = u[..., :D_MODEL], u[..., D_MODEL:2 * D_MODEL], u[..., 2 * D_MODEL:]
        hf = _hyena_filters(n, f_w1, f_b1, f_w2, f_b2, f_w3, f_b3, f_w4, f_freq)
        z = x1 * _fft_conv(v, hf[:, 0], bias[0])
        z = x2 * _fft_conv(z, hf[:, 1], bias[1])
        return (z @ out_w.astype(F32) + out_b.astype(F32)).astype(h.dtype)

    return one_sequence(h_ctx), one_sequence(h_lat)


def _gdn_features(h, in_w, conv_w, a_log, dt_bias):
    bsz, n, _ = h.shape
    proj = (h @ in_w).astype(F32)
    qkv = jax.nn.silu(_dwconv(proj[..., :GDN_CONV_DIM], conv_w.astype(F32)))
    q = qkv[..., :GDN_QK].reshape(bsz, n, GDN_K_HEADS, GDN_HEAD_K)
    k = qkv[..., GDN_QK:2 * GDN_QK].reshape(bsz, n, GDN_K_HEADS, GDN_HEAD_K)
    v = qkv[..., 2 * GDN_QK:].reshape(bsz, n, GDN_V_HEADS, GDN_HEAD_V)
    rep = GDN_V_HEADS // GDN_K_HEADS
    q = jnp.repeat(_l2norm(q), rep, axis=2)
    k = jnp.repeat(_l2norm(k), rep, axis=2)
    z = proj[..., GDN_CONV_DIM:GDN_CONV_DIM + GDN_V].reshape(bsz, n, GDN_V_HEADS, GDN_HEAD_V)
    ab = proj[..., GDN_CONV_DIM + GDN_V:].reshape(bsz, n, 2, 2, GDN_V_HEADS)
    g = -jnp.exp(a_log.astype(F32)) * jax.nn.softplus(ab[:, :, 0] + dt_bias.astype(F32))
    beta = jax.nn.sigmoid(ab[:, :, 1])
    return q, k, v, z, g, beta


def _gdn_chunked(q, k, v, g, beta, h0):
    bsz, n, heads, dk = k.shape
    dv = v.shape[-1]
    nc = n // GDN_CHUNK

    def chunks(t):
        t = t.reshape((bsz, nc, GDN_CHUNK, heads) + t.shape[3:])
        return jnp.moveaxis(t, 3, 1)

    q = chunks(q) * (dk ** -0.5)
    k = chunks(k)
    v = chunks(v)
    g = chunks(g)
    beta = chunks(beta)
    gc = jnp.cumsum(g, axis=-1)
    idx = jnp.arange(GDN_CHUNK)
    incl = idx[:, None] >= idx[None, :]
    strict = idx[:, None] > idx[None, :]
    decay = jnp.exp(jnp.where(incl, gc[..., :, None] - gc[..., None, :], -jnp.inf))
    kb = k * beta[..., None]
    lower = jnp.where(strict, jnp.einsum('bhnid,bhnjd->bhnij', kb, k) * decay, 0.0)
    tri = lower + jnp.eye(GDN_CHUNK, dtype=F32)
    u = lax.linalg.triangular_solve(tri, v * beta[..., None], left_side=True, lower=True,
                                    unit_diagonal=True)
    w = lax.linalg.triangular_solve(tri, kb * jnp.exp(gc)[..., None], left_side=True, lower=True,
                                    unit_diagonal=True)
    attn = jnp.where(incl, jnp.einsum('bhnid,bhnjd->bhnij', q, k) * decay, 0.0)
    qg = q * jnp.exp(gc)[..., None]
    kg = k * jnp.exp(gc[..., -1:] - gc)[..., None]
    gl = jnp.exp(gc[..., -1])
    xs = tuple(jnp.moveaxis(t, 2, 0) for t in (qg, kg, u, w, attn, gl))

    def step(state, inp):
        qg_i, kg_i, u_i, w_i, attn_i, gl_i = inp
        v_new = u_i - jnp.einsum('bhcd,bhde->bhce', w_i, state)
        o_i = (jnp.einsum('bhcd,bhde->bhce', qg_i, state)
               + jnp.einsum('bhcs,bhse->bhce', attn_i, v_new))
        state = state * gl_i[..., None, None] + jnp.einsum('bhcd,bhce->bhde', kg_i, v_new)
        return state, o_i

    h_last, o = lax.scan(step, h0, xs)
    o = jnp.transpose(o, (1, 0, 3, 2, 4)).reshape(bsz, n, heads, dv)
    return o, h_last


def _gdn_mixer(h_ctx, h_lat, in_w, conv_w, a_log, dt_bias, norm_g, out_w):
    qc, kc, vc, zc, gc, bc = _gdn_features(h_ctx, in_w, conv_w, a_log, dt_bias)
    ql, kl, vl, zl, gl, bl = _gdn_features(h_lat, in_w, conv_w, a_log, dt_bias)
    h0 = jnp.zeros((h_lat.shape[0], GDN_V_HEADS, GDN_HEAD_K, GDN_HEAD_V), F32)
    o_ctx = jnp.zeros_like(vc)
    o_lat = jnp.zeros_like(vl)
    for direction in range(2):
        rev = direction == 1
        oc, h_ctx_last = _gdn_chunked(_flip_time(qc, rev), _flip_time(kc, rev), _flip_time(vc, rev),
                                      _flip_time(gc[:, :, direction], rev),
                                      _flip_time(bc[:, :, direction], rev), h0)
        ol, _ = _gdn_chunked(_flip_time(ql, rev), _flip_time(kl, rev), _flip_time(vl, rev),
                             _flip_time(gl[:, :, direction], rev),
                             _flip_time(bl[:, :, direction], rev), h_ctx_last)
        o_ctx = o_ctx + _flip_time(oc, rev)
        o_lat = o_lat + _flip_time(ol, rev)

    def gated_out(o, z):
        o = o * lax.rsqrt(jnp.mean(o * o, axis=-1, keepdims=True) + EPS)
        o = o * norm_g.astype(F32) * jax.nn.silu(z)
        return o.reshape(o.shape[0], o.shape[1], GDN_V) @ out_w.astype(F32)

    return gated_out(o_ctx, zc).astype(h_ctx.dtype), gated_out(o_lat, zl).astype(h_lat.dtype)


def setup_inputs(seed: int = 0) -> dict:
    key = jax.random.key(seed)
    ks = iter(jax.random.split(key, 48))

    def nrm(shape, std):
        return jax.random.normal(next(ks), shape, F32) * std

    def uni(shape, lo, hi):
        return jax.random.uniform(next(ks), shape, F32, lo, hi)

    d = D_MODEL
    g_, p_, hg = S5_GROUPS, S5_STATE, S5_GROUP
    inp = {}
    inp['x'] = nrm((BATCH, SEQ, d), 1.0)
    inp['c'] = nrm((BATCH, d), 1.0)
    inp['ctx'] = nrm((BATCH, CTX_LEN, d), 1.0)
    inp['c_ctx'] = nrm((d,), 1.0)
    inp['ada_w'] = nrm((DEPTH, d, 6 * d), 0.5 * d ** -0.5)
    inp['ada_b'] = nrm((DEPTH, 6 * d), 0.01)
    inp['norm_g'] = 1.0 + nrm((DEPTH, 2, d), 0.01)
    inp['final_g'] = 1.0 + nrm((d,), 0.01)
    inp['ffn_w_gate'] = nrm((DEPTH, d, D_FF), d ** -0.5)
    inp['ffn_w_up'] = nrm((DEPTH, d, D_FF), d ** -0.5)
    inp['ffn_w_down'] = nrm((DEPTH, D_FF, d), D_FF ** -0.5)
    inp['s5_a_re'] = -0.5 + nrm((N_S5, 2, g_, p_), 0.01)
    inp['s5_a_im'] = jnp.pi * jnp.arange(p_, dtype=F32) + nrm((N_S5, 2, g_, p_), 0.01)
    inp['s5_log_dt'] = uni((N_S5, 2, g_), math.log(1e-3), math.log(1e-1))
    inp['s5_b_re'] = nrm((N_S5, 2, g_, p_, hg), (2 * hg) ** -0.5)
    inp['s5_b_im'] = nrm((N_S5, 2, g_, p_, hg), (2 * hg) ** -0.5)
    inp['s5_c_re'] = nrm((N_S5, 2, g_, hg, p_), p_ ** -0.5)
    inp['s5_c_im'] = nrm((N_S5, 2, g_, hg, p_), p_ ** -0.5)
    inp['s5_d'] = nrm((N_S5, d), 0.5)
    inp['s5_glu_w'] = nrm((N_S5, d, 2 * d), d ** -0.5)
    inp['s5_glu_b'] = nrm((N_S5, 2 * d), 0.01)
    inp['hy_in_w'] = nrm((N_HY, d, 3 * d), d ** -0.5)
    inp['hy_in_b'] = nrm((N_HY, 3 * d), 0.01)
    inp['hy_conv_w'] = nrm((N_HY, HY_CONV_W, 3 * d), HY_CONV_W ** -0.5)
    inp['hy_conv_b'] = nrm((N_HY, 3 * d), 0.01)
    inp['hy_f_w1'] = nrm((N_HY, HY_EMB, HY_FILTER_HIDDEN), HY_EMB ** -0.5)
    inp['hy_f_b1'] = nrm((N_HY, HY_FILTER_HIDDEN), 0.02)
    inp['hy_f_w2'] = nrm((N_HY, HY_FILTER_HIDDEN, HY_FILTER_HIDDEN), HY_FILTER_HIDDEN ** -0.5)
    inp['hy_f_b2'] = nrm((N_HY, HY_FILTER_HIDDEN), 0.02)
    inp['hy_f_w3'] = nrm((N_HY, HY_FILTER_HIDDEN, HY_FILTER_HIDDEN), HY_FILTER_HIDDEN ** -0.5)
    inp['hy_f_b3'] = nrm((N_HY, HY_FILTER_HIDDEN), 0.02)
    inp['hy_f_w4'] = nrm((N_HY, HY_FILTER_HIDDEN, HY_ORDER * 2 * d), HY_FILTER_HIDDEN ** -0.5)
    inp['hy_f_freq'] = 1.0 + nrm((N_HY, HY_FILTER_HIDDEN), 0.01)
    inp['hy_bias'] = nrm((N_HY, HY_ORDER, d), 1.0)
    inp['hy_out_w'] = nrm((N_HY, d, d), d ** -0.5)
    inp['hy_out_b'] = nrm((N_HY, d), 0.01)
    inp['gdn_in_w'] = nrm((N_GDN, d, GDN_PROJ), d ** -0.5)
    inp['gdn_conv_w'] = nrm((N_GDN, GDN_CONV_W, GDN_CONV_DIM), GDN_CONV_W ** -0.5)
    inp['gdn_a_log'] = jnp.log(uni((N_GDN, 2, GDN_V_HEADS), 1.0, 16.0))
    dt = jnp.exp(uni((N_GDN, 2, GDN_V_HEADS), math.log(1e-3), math.log(1e-1)))
    inp['gdn_dt_bias'] = dt + jnp.log(-jnp.expm1(-dt))
    inp['gdn_norm_g'] = 1.0 + nrm((N_GDN, GDN_HEAD_V), 0.01)
    inp['gdn_out_w'] = nrm((N_GDN, GDN_V, d), GDN_V ** -0.5)
    return inp


def reference(x, c, ctx, c_ctx, ada_w, ada_b, norm_g, final_g, ffn_w_gate, ffn_w_up, ffn_w_down,
              s5_a_re, s5_a_im, s5_log_dt, s5_b_re, s5_b_im, s5_c_re, s5_c_im, s5_d, s5_glu_w,
              s5_glu_b, hy_in_w, hy_in_b, hy_conv_w, hy_conv_b, hy_f_w1, hy_f_b1, hy_f_w2, hy_f_b2,
              hy_f_w3, hy_f_b3, hy_f_w4, hy_f_freq, hy_bias, hy_out_w, hy_out_b, gdn_in_w,
              gdn_conv_w, gdn_a_log, gdn_dt_bias, gdn_norm_g, gdn_out_w):
    silu_c = jax.nn.silu(c)
    silu_cc = jax.nn.silu(c_ctx)
    for i in range(DEPTH):
        kind, j = i % N_MIXERS, i // N_MIXERS
        col_major = (j % 2) == 1
        sh1, sc1, gt1, sh2, sc2, gt2 = jnp.split((silu_c @ ada_w[i] + ada_b[i])[:, None, :], 6, axis=-1)
        csh1, csc1, cgt1, csh2, csc2, cgt2 = jnp.split(silu_cc @ ada_w[i] + ada_b[i], 6, axis=-1)
        h_lat = _grid_order(_rmsnorm(x, norm_g[i, 0]) * (1.0 + sc1) + sh1, col_major)
        h_ctx = _rmsnorm(ctx, norm_g[i, 0]) * (1.0 + csc1) + csh1
        if kind == 0:
            o_ctx, o_lat = _s5_mixer(h_ctx, h_lat, s5_a_re[j], s5_a_im[j], s5_log_dt[j], s5_b_re[j],
                                     s5_b_im[j], s5_c_re[j], s5_c_im[j], s5_d[j], s5_glu_w[j],
                                     s5_glu_b[j])
        elif kind == 1:
            o_ctx, o_lat = _hyena_mixer(h_ctx, h_lat, hy_in_w[j], hy_in_b[j], hy_conv_w[j],
                                        hy_conv_b[j], hy_f_w1[j], hy_f_b1[j], hy_f_w2[j], hy_f_b2[j],
                                        hy_f_w3[j], hy_f_b3[j], hy_f_w4[j], hy_f_freq[j], hy_bias[j],
                                        hy_out_w[j], hy_out_b[j])
        else:
            o_ctx, o_lat = _gdn_mixer(h_ctx, h_lat, gdn_in_w[j], gdn_conv_w[j], gdn_a_log[j],
                                      gdn_dt_bias[j], gdn_norm_g[j], gdn_out_w[j])
        x = x + gt1 * _grid_unorder(o_lat, col_major)
        x = x + gt2 * _swiglu(_rmsnorm(x, norm_g[i, 1]) * (1.0 + sc2) + sh2,
                              ffn_w_gate[i], ffn_w_up[i], ffn_w_down[i])
        if i < DEPTH - 1:
            ctx = ctx + cgt1 * o_ctx
            ctx = ctx + cgt2 * _swiglu(_rmsnorm(ctx, norm_g[i, 1]) * (1.0 + csc2) + csh2,
                                       ffn_w_gate[i], ffn_w_up[i], ffn_w_down[i])
    return _rmsnorm(x, final_g)
```

```cpp
#include <hip/hip_runtime.h>
#include <stdint.h>
#include <math.h>

namespace {
constexpr int D = 2048, NBATCH = 2, SEQ = 4096, CTXL = 256, DEPTH = 4, DFF = 5632;
constexpr int ML = NBATCH * SEQ, MC = NBATCH * CTXL, MT = ML + MC;
constexpr int G = 128, P = 64, HG = 16;
constexpr int NMOD = 6 * D;
constexpr int GDN_PROJ = 12416, GDN_CONV = 8192, GDN_V = 4096;

__device__ __forceinline__ float silu_f(float x) { return x / (1.0f + expf(-x)); }
__device__ __forceinline__ float sigmoid_f(float x) { return 1.0f / (1.0f + expf(-x)); }
__device__ __forceinline__ float gelu_tanh_f(float x) { return 0.5f * x * (1.0f + tanhf(0.7978845608028654f * (x + 0.044715f * x * x * x))); }
__device__ __forceinline__ int stream_of(int row) { return row < ML ? row / SEQ : 2; }
__device__ __forceinline__ float wave_sum(float v) {
#pragma unroll
  for (int o = 32; o > 0; o >>= 1) v += __shfl_xor(v, o);
  return v;
}
__device__ __forceinline__ float block_sum(float v, float* red) {
  v = wave_sum(v);
  const int w = threadIdx.x >> 6, nw = blockDim.x >> 6;
  __syncthreads();
  if ((threadIdx.x & 63) == 0) red[w] = v;
  __syncthreads();
  float s = 0.f;
  for (int i = 0; i < nw; ++i) s += red[i];
  return s;
}

__global__ void k_silu_vec(const float* c, const float* cctx, float* sv) {
  int i = blockIdx.x * blockDim.x + threadIdx.x;
  if (i < 2 * D) sv[i] = silu_f(c[i]);
  else if (i < 3 * D) sv[i] = silu_f(cctx[i - 2 * D]);
}
__global__ void k_mod(const float* sv, const float* ada_w, const float* ada_b, float* mod) {
  const int total = DEPTH * NMOD;
  for (int idx = blockIdx.x * blockDim.x + threadIdx.x; idx < total; idx += gridDim.x * blockDim.x) {
    const int i = idx / NMOD, n = idx % NMOD;
    const float* W = ada_w + (size_t)i * D * NMOD + n;
    float a0 = 0.f, a1 = 0.f, a2 = 0.f;
    for (int k = 0; k < D; ++k) { const float w = W[(size_t)k * NMOD]; a0 += sv[k] * w; a1 += sv[D + k] * w; a2 += sv[2 * D + k] * w; }
    const float b = ada_b[i * NMOD + n];
    mod[(size_t)(i * 3 + 0) * NMOD + n] = a0 + b; mod[(size_t)(i * 3 + 1) * NMOD + n] = a1 + b; mod[(size_t)(i * 3 + 2) * NMOD + n] = a2 + b;
  }
}
__global__ void k_modnorm(const float* src, const float* g, const float* modl, int shi, int sci, float* dst, int M) {
  __shared__ float red[16];
  for (int row = blockIdx.x; row < M; row += gridDim.x) {
    const int r = stream_of(row);
    const float* x = src + (size_t)row * D;
    float ss = 0.f;
    for (int c = threadIdx.x; c < D; c += blockDim.x) { const float v = x[c]; ss += v * v; }
    ss = block_sum(ss, red);
    const float rstd = rsqrtf(ss / D + 1e-6f);
    const float* sh = modl + (size_t)r * NMOD + shi * D; const float* sc = modl + (size_t)r * NMOD + sci * D;
    for (int c = threadIdx.x; c < D; c += blockDim.x) dst[(size_t)row * D + c] = x[c] * rstd * g[c] * (1.0f + sc[c]) + sh[c];
  }
}
__global__ void k_final(const float* src, const float* g, float* dst, int M) {
  __shared__ float red[16];
  for (int row = blockIdx.x; row < M; row += gridDim.x) {
    const float* x = src + (size_t)row * D;
    float ss = 0.f;
    for (int c = threadIdx.x; c < D; c += blockDim.x) { const float v = x[c]; ss += v * v; }
    ss = block_sum(ss, red);
    const float rstd = rsqrtf(ss / D + 1e-6f);
    for (int c = threadIdx.x; c < D; c += blockDim.x) dst[(size_t)row * D + c] = x[c] * rstd * g[c];
  }
}
__global__ void k_copy_x(const float* x, const float* ctx, float* xb) {
  const size_t n = (size_t)MT * D;
  for (size_t i = (size_t)blockIdx.x * blockDim.x + threadIdx.x; i < n; i += (size_t)gridDim.x * blockDim.x)
    xb[i] = i < (size_t)ML * D ? x[i] : ctx[i - (size_t)ML * D];
}

__global__ __launch_bounds__(256) void k_gemm(const float* __restrict__ A, int lda, const float* __restrict__ W, int ldw, const float* __restrict__ bias,
                                              float* __restrict__ C, int ldc, int M, int N, int K) {
  __shared__ float As[16][128];
  __shared__ float Ws[16][128];
  const int tid = threadIdx.x, tx = tid & 15, ty = tid >> 4;
  const int tilesN = N / 128, tiles = (M / 128) * tilesN;
  for (int t = blockIdx.x; t < tiles; t += gridDim.x) {
    const int tm = t / tilesN, tn = t % tilesN;
    float acc[8][8];
#pragma unroll
    for (int i = 0; i < 8; ++i)
#pragma unroll
      for (int j = 0; j < 8; ++j) acc[i][j] = 0.f;
    for (int k0 = 0; k0 < K; k0 += 16) {
#pragma unroll
      for (int it = 0; it < 2; ++it) {
        const int e = tid + it * 256, row = e >> 2, k4 = e & 3;
        const float4 v = *(const float4*)(A + (size_t)(tm * 128 + row) * lda + k0 + k4 * 4);
        As[k4 * 4 + 0][row] = v.x; As[k4 * 4 + 1][row] = v.y; As[k4 * 4 + 2][row] = v.z; As[k4 * 4 + 3][row] = v.w;
      }
#pragma unroll
      for (int it = 0; it < 2; ++it) {
        const int e = tid + it * 256, kk = e >> 5, c4 = e & 31;
        *(float4*)&Ws[kk][c4 * 4] = *(const float4*)(W + (size_t)(k0 + kk) * ldw + tn * 128 + c4 * 4);
      }
      __syncthreads();
#pragma unroll
      for (int kk = 0; kk < 16; ++kk) {
        const float4 a0 = *(const float4*)&As[kk][ty * 4], a1 = *(const float4*)&As[kk][64 + ty * 4];
        const float4 b0 = *(const float4*)&Ws[kk][tx * 4], b1 = *(const float4*)&Ws[kk][64 + tx * 4];
        const float a[8] = {a0.x, a0.y, a0.z, a0.w, a1.x, a1.y, a1.z, a1.w};
        const float b[8] = {b0.x, b0.y, b0.z, b0.w, b1.x, b1.y, b1.z, b1.w};
#pragma unroll
        for (int i = 0; i < 8; ++i)
#pragma unroll
          for (int j = 0; j < 8; ++j) acc[i][j] += a[i] * b[j];
      }
      __syncthreads();
    }
#pragma unroll
    for (int i = 0; i < 8; ++i) {
      const int row = tm * 128 + (i < 4 ? ty * 4 + i : 64 + ty * 4 + i - 4);
#pragma unroll
      for (int jh = 0; jh < 2; ++jh) {
        const int col = tn * 128 + jh * 64 + tx * 4;
        float4 o;
        o.x = acc[i][jh * 4 + 0]; o.y = acc[i][jh * 4 + 1]; o.z = acc[i][jh * 4 + 2]; o.w = acc[i][jh * 4 + 3];
        if (bias) { o.x += bias[col]; o.y += bias[col + 1]; o.z += bias[col + 2]; o.w += bias[col + 3]; }
        *(float4*)(C + (size_t)row * ldc + col) = o;
      }
    }
  }
}

__global__ void k_resid(float* x, const float* y, int ldy, const float* modl, int gi, int M) {
  const size_t n = (size_t)M * D;
  for (size_t i = (size_t)blockIdx.x * blockDim.x + threadIdx.x; i < n; i += (size_t)gridDim.x * blockDim.x) {
    const int row = (int)(i / D), c = (int)(i % D), r = stream_of(row);
    x[i] += modl[(size_t)r * NMOD + gi * D + c] * y[(size_t)row * ldy + c];
  }
}
__global__ void k_resid_glu(float* x, const float* gz, const float* modl, int gi, int M) {
  const size_t n = (size_t)M * D;
  for (size_t i = (size_t)blockIdx.x * blockDim.x + threadIdx.x; i < n; i += (size_t)gridDim.x * blockDim.x) {
    const int row = (int)(i / D), c = (int)(i % D), r = stream_of(row);
    const float a = gz[(size_t)row * 2 * D + c], b = gz[(size_t)row * 2 * D + D + c];
    x[i] += modl[(size_t)r * NMOD + gi * D + c] * (a * sigmoid_f(b));
  }
}
__global__ void k_swiglu(const float* g, const float* u, float* act, size_t n) {
  for (size_t i = (size_t)blockIdx.x * blockDim.x + threadIdx.x; i < n; i += (size_t)gridDim.x * blockDim.x) act[i] = silu_f(g[i]) * u[i];
}

__global__ __launch_bounds__(128) void k_s5_scan(const float* __restrict__ h, const float* a_re, const float* a_im, const float* log_dt, const float* b_re, const float* b_im,
                          const float* c_re, const float* c_im, float* ydir, int col_major) {
  const int lane = threadIdx.x & 63, wave = (blockIdx.x * blockDim.x + threadIdx.x) >> 6, nw = (gridDim.x * blockDim.x) >> 6;
  for (int item = wave; item < NBATCH * G * 2; item += nw) {
    const int dir = item & 1, g = (item >> 1) % G, b = item / (2 * G);
    const int p = lane, gp = (dir * G + g) * P + p;
    const float are = a_re[gp], aim = a_im[gp], dt = expf(log_dt[dir * G + g]);
    const float mag = expf(are * dt), lr = mag * cosf(aim * dt), li = mag * sinf(aim * dt);
    const float nr = lr - 1.0f, ni = li, den = are * are + aim * aim;
    const float qr = (nr * are + ni * aim) / den, qi = (ni * are - nr * aim) / den;
    float Br[16], Bi[16], Cr[16], Ci[16];
#pragma unroll
    for (int c = 0; c < 16; ++c) { const float br = b_re[(size_t)gp * 16 + c], bi = b_im[(size_t)gp * 16 + c]; Br[c] = qr * br - qi * bi; Bi[c] = qr * bi + qi * br; }
#pragma unroll
    for (int i = 0; i < 16; ++i) { Cr[i] = c_re[((size_t)(dir * G + g) * 16 + i) * P + p]; Ci[i] = c_im[((size_t)(dir * G + g) * 16 + i) * P + p]; }
    float hr = 0.f, hi = 0.f;
    for (int s = 0; s < CTXL + SEQ; ++s) {
      int row;
      if (s < CTXL) { const int t = dir ? CTXL - 1 - s : s; row = ML + b * CTXL + t; }
      else { int q = s - CTXL; if (dir) q = SEQ - 1 - q; const int t = col_major ? ((q & 63) * 64 + (q >> 6)) : q; row = b * SEQ + t; }
      const float* u = h + (size_t)row * D + g * 16;
      float ur = 0.f, ui = 0.f;
#pragma unroll
      for (int c = 0; c < 16; ++c) { const float uc = u[c]; ur += Br[c] * uc; ui += Bi[c] * uc; }
      const float nhr = lr * hr - li * hi + ur, nhi = lr * hi + li * hr + ui;
      hr = nhr; hi = nhi;
      float outv = 0.f;
#pragma unroll
      for (int i = 0; i < 16; ++i) { float v = Cr[i] * hr - Ci[i] * hi; v = wave_sum(v); if (lane == i) outv = v; }
      if (lane < 16) ydir[((size_t)dir * MT + row) * D + g * 16 + lane] = outv;
    }
  }
}
__global__ void k_s5_gelu(const float* h, const float* dvec, const float* ydir, float* z) {
  const size_t n = (size_t)MT * D;
  for (size_t i = (size_t)blockIdx.x * blockDim.x + threadIdx.x; i < n; i += (size_t)gridDim.x * blockDim.x) {
    const int c = (int)(i % D);
    z[i] = gelu_tanh_f(h[i] * dvec[c] + ydir[i] + ydir[n + i]);
  }
}

__device__ __forceinline__ double dsin_red(double x) {
  const double k = rint(x * 0.15915494309189535);
  const double r = x - k * 6.283185307179586;
  return (double)sinf((float)r);
}
__global__ __launch_bounds__(512) void k_hy_hdn(const float* w1, const float* b1, const float* w2, const float* b2, const float* w3, const float* b3, const float* freq, float* hdn3) {
  __shared__ double sh[8][64];
  const int lane = threadIdx.x & 63, wl = threadIdx.x >> 6;
  for (int tb = blockIdx.x * 8; tb < SEQ + CTXL; tb += gridDim.x * 8) {
    const int tt = tb + wl;
    const int n = tt < SEQ ? SEQ : CTXL, t = tt < SEQ ? tt : tt - SEQ;
    const double t_unit = (double)t / (double)(n - 1);
    const double fq = (double)freq[lane];
    double a = (double)b1[lane] + t_unit * (double)w1[0 * 64 + lane];
    for (int kb = 0; kb < 16; ++kb) {
      const double band = 1e-4 + (15.0 - 1e-4) * (double)kb / 15.0;
      double fr = (double)t * band / (double)n; fr -= floor(fr);
      const float ang = (float)(2.0 * M_PI * fr);
      a += (double)cosf(ang) * (double)w1[(1 + kb) * 64 + lane] - (double)sinf(ang) * (double)w1[(17 + kb) * 64 + lane];
    }
    double hcur = dsin_red(fq * a);
    sh[wl][lane] = hcur; __syncthreads();
    a = (double)b2[lane];
    for (int e = 0; e < 64; ++e) a += sh[wl][e] * (double)w2[e * 64 + lane];
    hcur = dsin_red(fq * a);
    __syncthreads(); sh[wl][lane] = hcur; __syncthreads();
    a = (double)b3[lane];
    for (int e = 0; e < 64; ++e) a += sh[wl][e] * (double)w3[e * 64 + lane];
    hcur = dsin_red(fq * a);
    __syncthreads();
    hdn3[(size_t)tt * 64 + lane] = (float)hcur;
  }
}
__global__ void k_hy_filt(const float* hdn3, const float* w4, float* raw) {
  const size_t n = (size_t)(SEQ + CTXL) * 8192;
  for (size_t i = (size_t)blockIdx.x * blockDim.x + threadIdx.x; i < n; i += (size_t)gridDim.x * blockDim.x) {
    const int tt = (int)(i / 8192), col = (int)(i % 8192), c = col % D;
    const int nn = tt < SEQ ? SEQ : CTXL, t = tt < SEQ ? tt : tt - SEQ;
    const float t_unit = (float)t / (float)(nn - 1);
    const float mind = -3.0701134573253945f, maxd = -15.350567286626973f;
    const float delta = fabsf(mind + (maxd - mind) * (float)c / (float)(D - 1));
    float a = 0.f;
    for (int m = 0; m < 64; ++m) a += hdn3[(size_t)tt * 64 + m] * w4[(size_t)m * 8192 + col];
    raw[i] = a * expf(-t_unit * delta);
  }
}
__global__ void k_hy_fnorm(const float* raw, float* fnorm) {
  const int idx = blockIdx.x * blockDim.x + threadIdx.x;
  if (idx >= 2 * 2 * D) return;
  const int c = idx % D, o = (idx / D) % 2, ns = idx / (2 * D);
  const int n = ns ? CTXL : SEQ, toff = ns ? SEQ : 0;
  float s = 0.f;
  for (int t = 0; t < n; ++t) s += fabsf(raw[(size_t)(toff + t) * 8192 + o * 4096 + c]);
  for (int t = 1; t < n; ++t) s += fabsf(raw[(size_t)(toff + t) * 8192 + o * 4096 + 2048 + c]);
  fnorm[idx] = s;
}
__global__ void k_hy_dwconv(const float* u, const float* cw, const float* cb, float* uc) {
  const size_t n = (size_t)MT * 3 * D;
  for (size_t i = (size_t)blockIdx.x * blockDim.x + threadIdx.x; i < n; i += (size_t)gridDim.x * blockDim.x) {
    const int row = (int)(i / (3 * D)), col = (int)(i % (3 * D));
    int t, len;
    if (row < ML) { t = row % SEQ; len = SEQ; } else { t = (row - ML) % CTXL; len = CTXL; }
    float a = cb[col];
#pragma unroll
    for (int k = 0; k < 3; ++k) { const int tt = t + k - 1; if (tt >= 0 && tt < len) a += u[(size_t)(row + k - 1) * 3 * D + col] * cw[k * 3 * D + col]; }
    uc[i] = a;
  }
}
__global__ void k_hy_conv(const float* zin, int ldz, const float* xk, int ldx, const float* raw, const float* fnorm, const float* bias, int o, float* zout, int ldo) {
  const size_t n = (size_t)MT * D;
  for (size_t i = (size_t)blockIdx.x * blockDim.x + threadIdx.x; i < n; i += (size_t)gridDim.x * blockDim.x) {
    const int row = (int)(i / D), c = (int)(i % D);
    int t, len, base, toff, ns;
    if (row < ML) { t = row % SEQ; len = SEQ; base = row - t; toff = 0; ns = 0; } else { t = (row - ML) % CTXL; len = CTXL; base = row - t; toff = SEQ; ns = 1; }
    const float* f0 = raw + (size_t)toff * 8192 + o * 4096 + c;
    const float* f1 = f0 + 2048;
    float a = 0.f;
    for (int s = 0; s <= t; ++s) a += zin[(size_t)(base + s) * ldz + c] * f0[(size_t)(t - s) * 8192];
    for (int s = t + 1; s < len; ++s) a += zin[(size_t)(base + s) * ldz + c] * f1[(size_t)(s - t) * 8192];
    const float y = a / fnorm[(ns * 2 + o) * D + c] + zin[(size_t)row * ldz + c] * bias[o * D + c];
    zout[(size_t)row * ldo + c] = xk[(size_t)row * ldx + c] * y;
  }
}

__global__ void k_gdn_conv(const float* proj, const float* cw, float* qkv) {
  const size_t n = (size_t)MT * GDN_CONV;
  for (size_t i = (size_t)blockIdx.x * blockDim.x + threadIdx.x; i < n; i += (size_t)gridDim.x * blockDim.x) {
    const int row = (int)(i / GDN_CONV), col = (int)(i % GDN_CONV);
    int t, len;
    if (row < ML) { t = row % SEQ; len = SEQ; } else { t = (row - ML) % CTXL; len = CTXL; }
    float a = 0.f;
#pragma unroll
    for (int k = 0; k < 5; ++k) { const int tt = t + k - 2; if (tt >= 0 && tt < len) a += proj[(size_t)(row + k - 2) * GDN_PROJ + col] * cw[k * GDN_CONV + col]; }
    qkv[i] = silu_f(a);
  }
}
__global__ void k_gdn_l2(float* qkv) {
  const int lane = threadIdx.x & 63;
  const size_t wave = ((size_t)blockIdx.x * blockDim.x + threadIdx.x) >> 6, nw = ((size_t)gridDim.x * blockDim.x) >> 6;
  for (size_t item = wave; item < (size_t)MT * 32; item += nw) {
    float* p = qkv + (item / 32) * GDN_CONV + (item % 32) * 128;
    const float a = p[lane], b = p[lane + 64];
    const float ss = wave_sum(a * a + b * b);
    const float r = rsqrtf(ss + 1e-6f);
    p[lane] = a * r; p[lane + 64] = b * r;
  }
}
__global__ void k_gdn_gates(const float* proj, const float* a_log, const float* dt_bias, float* gg, float* bt) {
  const size_t n = (size_t)MT * 64;
  for (size_t i = (size_t)blockIdx.x * blockDim.x + threadIdx.x; i < n; i += (size_t)gridDim.x * blockDim.x) {
    const int row = (int)(i / 64), j = (int)(i % 64);
    const float a = proj[(size_t)row * GDN_PROJ + GDN_CONV + GDN_V + j], b = proj[(size_t)row * GDN_PROJ + GDN_CONV + GDN_V + 64 + j];
    const float xx = a + dt_bias[j];
    const float sp = xx > 20.f ? xx : log1pf(expf(xx));
    gg[i] = -expf(a_log[j]) * sp;
    bt[i] = sigmoid_f(b);
  }
}
__global__ __launch_bounds__(128) void k_gdn_rec(const float* __restrict__ qkv, const float* __restrict__ gg, const float* __restrict__ bt, float* odir) {
  const int e = threadIdx.x;
  for (int item = blockIdx.x; item < NBATCH * 32 * 2; item += gridDim.x) {
    const int dir = item & 1, hv = (item >> 1) & 31, b = item >> 6, hk = hv >> 1;
    float S[128];
#pragma unroll
    for (int d = 0; d < 128; ++d) S[d] = 0.f;
    for (int s = 0; s < CTXL + SEQ; ++s) {
      int row;
      if (s < CTXL) { const int t = dir ? CTXL - 1 - s : s; row = ML + b * CTXL + t; }
      else { int q = s - CTXL; if (dir) q = SEQ - 1 - q; row = b * SEQ + q; }
      const float* qp = qkv + (size_t)row * GDN_CONV + hk * 128;
      const float* kp = qkv + (size_t)row * GDN_CONV + 2048 + hk * 128;
      const float v = qkv[(size_t)row * GDN_CONV + 4096 + hv * 128 + e];
      const float a = expf(gg[(size_t)row * 64 + dir * 32 + hv]), beta = bt[(size_t)row * 64 + dir * 32 + hv];
      float dot = 0.f;
#pragma unroll
      for (int d = 0; d < 128; ++d) { S[d] *= a; dot += S[d] * kp[d]; }
      const float vn = beta * (v - dot);
      float o = 0.f;
#pragma unroll
      for (int d = 0; d < 128; ++d) { S[d] += kp[d] * vn; o += S[d] * qp[d]; }
      odir[((size_t)dir * MT + row) * GDN_V + hv * 128 + e] = o * 0.08838834764831845f;
    }
  }
}
__global__ void k_gdn_gate(const float* odir, const float* proj, const float* norm_g, float* og) {
  const int lane = threadIdx.x & 63;
  const size_t wave = ((size_t)blockIdx.x * blockDim.x + threadIdx.x) >> 6, nw = ((size_t)gridDim.x * blockDim.x) >> 6;
  for (size_t item = wave; item < (size_t)MT * 32; item += nw) {
    const size_t row = item / 32; const int hv = (int)(item % 32);
    const size_t o0 = row * GDN_V + hv * 128, o1 = ((size_t)MT + row) * GDN_V + hv * 128;
    const float a = odir[o0 + lane] + odir[o1 + lane], b = odir[o0 + lane + 64] + odir[o1 + lane + 64];
    const float ms = wave_sum(a * a + b * b) * (1.0f / 128.0f);
    const float r = rsqrtf(ms + 1e-6f);
    const float za = proj[row * GDN_PROJ + GDN_CONV + hv * 128 + lane], zb = proj[row * GDN_PROJ + GDN_CONV + hv * 128 + lane + 64];
    og[o0 + lane] = a * r * norm_g[lane] * silu_f(za);
    og[o0 + lane + 64] = b * r * norm_g[lane + 64] * silu_f(zb);
  }
}
}

extern "C" void kernel_launch(void* const* d_in, const int* in_sizes, int n_in, void* d_out, int out_size, void* d_ws, size_t ws_size, hipStream_t stream) {
  const float* x = (const float*)d_in[0]; const float* cvec = (const float*)d_in[1]; const float* ctx = (const float*)d_in[2]; const float* c_ctx = (const float*)d_in[3];
  const float* ada_w = (const float*)d_in[4]; const float* ada_b = (const float*)d_in[5]; const float* norm_g = (const float*)d_in[6]; const float* final_g = (const float*)d_in[7];
  const float* ffn_wg = (const float*)d_in[8]; const float* ffn_wu = (const float*)d_in[9]; const float* ffn_wd = (const float*)d_in[10];
  const float* s5_a_re = (const float*)d_in[11]; const float* s5_a_im = (const float*)d_in[12]; const float* s5_log_dt = (const float*)d_in[13];
  const float* s5_b_re = (const float*)d_in[14]; const float* s5_b_im = (const float*)d_in[15]; const float* s5_c_re = (const float*)d_in[16]; const float* s5_c_im = (const float*)d_in[17];
  const float* s5_d = (const float*)d_in[18]; const float* s5_glu_w = (const float*)d_in[19]; const float* s5_glu_b = (const float*)d_in[20];
  const float* hy_in_w = (const float*)d_in[21]; const float* hy_in_b = (const float*)d_in[22]; const float* hy_conv_w = (const float*)d_in[23]; const float* hy_conv_b = (const float*)d_in[24];
  const float* hy_f_w1 = (const float*)d_in[25]; const float* hy_f_b1 = (const float*)d_in[26]; const float* hy_f_w2 = (const float*)d_in[27]; const float* hy_f_b2 = (const float*)d_in[28];
  const float* hy_f_w3 = (const float*)d_in[29]; const float* hy_f_b3 = (const float*)d_in[30]; const float* hy_f_w4 = (const float*)d_in[31]; const float* hy_f_freq = (const float*)d_in[32];
  const float* hy_bias = (const float*)d_in[33]; const float* hy_out_w = (const float*)d_in[34]; const float* hy_out_b = (const float*)d_in[35];
  const float* gdn_in_w = (const float*)d_in[36]; const float* gdn_conv_w = (const float*)d_in[37]; const float* gdn_a_log = (const float*)d_in[38]; const float* gdn_dt_bias = (const float*)d_in[39];
  const float* gdn_norm_g = (const float*)d_in[40]; const float* gdn_out_w = (const float*)d_in[41];
  float* out = (float*)d_out;

  float* ws = (float*)d_ws; size_t off = 0;
  auto take = [&](size_t n) { float* p = ws + off; off += (n + 63) & ~(size_t)63; return p; };
  float* sv = take(3 * D);
  float* mod = take((size_t)DEPTH * 3 * NMOD);
  float* xb = take((size_t)MT * D);
  float* hb = take((size_t)MT * D);
  float* B1 = take((size_t)MT * GDN_PROJ);
  float* B2 = take((size_t)MT * GDN_CONV);
  float* B3 = take((size_t)2 * MT * GDN_V);
  float* B4 = take((size_t)MT * GDN_V);
  float* raw = take((size_t)(SEQ + CTXL) * 8192);
  float* hdn3 = take((size_t)(SEQ + CTXL) * 64);
  float* fnorm = take(4 * D);
  float* gg = take((size_t)MT * 64);
  float* bt = take((size_t)MT * 64);
  (void)ws_size; (void)n_in; (void)in_sizes; (void)out_size;

  const int GB = 2048, TB = 256;
  auto gemm = [&](const float* A, int lda, const float* W, int ldw, const float* bias, float* C, int ldc, int M, int N, int K) {
    hipLaunchKernelGGL(k_gemm, dim3(1024), dim3(256), 0, stream, A, lda, W, ldw, bias, C, ldc, M, N, K);
  };

  hipLaunchKernelGGL(k_silu_vec, dim3((3 * D + 255) / 256), dim3(256), 0, stream, cvec, c_ctx, sv);
  hipLaunchKernelGGL(k_mod, dim3((DEPTH * NMOD + 255) / 256), dim3(256), 0, stream, sv, ada_w, ada_b, mod);
  hipLaunchKernelGGL(k_copy_x, dim3(GB), dim3(TB), 0, stream, x, ctx, xb);

  for (int i = 0; i < DEPTH; ++i) {
    const int kind = i % 3, j = i / 3, col_major = (j % 2) == 1;
    const float* modl = mod + (size_t)i * 3 * NMOD;
    hipLaunchKernelGGL(k_modnorm, dim3(GB), dim3(TB), 0, stream, xb, norm_g + (size_t)(i * 2 + 0) * D, modl, 0, 1, hb, MT);
    if (kind == 0) {
      const size_t o1 = (size_t)j * 2 * G * P, o2 = (size_t)j * 2 * G, o3 = (size_t)j * 2 * G * P * HG;
      float* ydir = B3; float* z = B4; float* gz = B2;
      hipLaunchKernelGGL(k_s5_scan, dim3(256), dim3(128), 0, stream, hb, s5_a_re + o1, s5_a_im + o1, s5_log_dt + o2, s5_b_re + o3, s5_b_im + o3, s5_c_re + o3, s5_c_im + o3, ydir, col_major);
      hipLaunchKernelGGL(k_s5_gelu, dim3(GB), dim3(TB), 0, stream, hb, s5_d + (size_t)j * D, ydir, z);
      gemm(z, D, s5_glu_w + (size_t)j * D * 2 * D, 2 * D, s5_glu_b + (size_t)j * 2 * D, gz, 2 * D, MT, 2 * D, D);
      hipLaunchKernelGGL(k_resid_glu, dim3(GB), dim3(TB), 0, stream, xb, gz, modl, 2, MT);
    } else if (kind == 1) {
      float* u = B1; float* uc = B2; float* z1 = B3; float* z2 = B4; float* o = B1;
      hipLaunchKernelGGL(k_hy_hdn, dim3(256), dim3(512), 0, stream, hy_f_w1, hy_f_b1, hy_f_w2, hy_f_b2, hy_f_w3, hy_f_b3, hy_f_freq, hdn3);
      hipLaunchKernelGGL(k_hy_filt, dim3(GB), dim3(TB), 0, stream, hdn3, hy_f_w4, raw);
      hipLaunchKernelGGL(k_hy_fnorm, dim3((4 * D + 255) / 256), dim3(256), 0, stream, raw, fnorm);
      gemm(hb, D, hy_in_w, 3 * D, hy_in_b, u, 3 * D, MT, 3 * D, D);
      hipLaunchKernelGGL(k_hy_dwconv, dim3(GB), dim3(TB), 0, stream, u, hy_conv_w, hy_conv_b, uc);
      hipLaunchKernelGGL(k_hy_conv, dim3(4096), dim3(TB), 0, stream, uc, 3 * D, uc + D, 3 * D, raw, fnorm, hy_bias, 0, z1, D);
      hipLaunchKernelGGL(k_hy_conv, dim3(4096), dim3(TB), 0, stream, z1, D, uc + 2 * D, 3 * D, raw, fnorm, hy_bias, 1, z2, D);
      gemm(z2, D, hy_out_w, D, hy_out_b, o, D, MT, D, D);
      hipLaunchKernelGGL(k_resid, dim3(GB), dim3(TB), 0, stream, xb, o, D, modl, 2, MT);
    } else {
      float* proj = B1; float* qkv = B2; float* odir = B3; float* og = B4; float* o = B2;
      gemm(hb, D, gdn_in_w, GDN_PROJ, nullptr, proj, GDN_PROJ, MT, GDN_PROJ, D);
      hipLaunchKernelGGL(k_gdn_conv, dim3(GB), dim3(TB), 0, stream, proj, gdn_conv_w, qkv);
      hipLaunchKernelGGL(k_gdn_l2, dim3(GB), dim3(TB), 0, stream, qkv);
      hipLaunchKernelGGL(k_gdn_gates, dim3(GB), dim3(TB), 0, stream, proj, gdn_a_log, gdn_dt_bias, gg, bt);
      hipLaunchKernelGGL(k_gdn_rec, dim3(128), dim3(128), 0, stream, qkv, gg, bt, odir);
      hipLaunchKernelGGL(k_gdn_gate, dim3(GB), dim3(TB), 0, stream, odir, proj, gdn_norm_g, og);
      gemm(og, GDN_V, gdn_out_w, D, nullptr, o, D, MT, D, GDN_V);
      hipLaunchKernelGGL(k_resid, dim3(GB), dim3(TB), 0, stream, xb, o, D, modl, 2, MT);
    }
    {
      float* gt = B1; float* ut = B2; float* act = B3; float* dn = B4;
      hipLaunchKernelGGL(k_modnorm, dim3(GB), dim3(TB), 0, stream, xb, norm_g + (size_t)(i * 2 + 1) * D, modl, 3, 4, hb, MT);
      gemm(hb, D, ffn_wg + (size_t)i * D * DFF, DFF, nullptr, gt, DFF, MT, DFF, D);
      gemm(hb, D, ffn_wu + (size_t)i * D * DFF, DFF, nullptr, ut, DFF, MT, DFF, D);
      hipLaunchKernelGGL(k_swiglu, dim3(GB), dim3(TB), 0, stream, gt, ut, act, (size_t)MT * DFF);
      gemm(act, DFF, ffn_wd + (size_t)i * DFF * D, D, nullptr, dn, D, MT, D, DFF);
      hipLaunchKernelGGL(k_resid, dim3(GB), dim3(TB), 0, stream, xb, dn, D, modl, 5, MT);
    }
  }
  hipLaunchKernelGGL(k_final, dim3(GB), dim3(TB), 0, stream, xb, final_g, out, ML);
}
```

```cpp
#include <hip/hip_runtime.h>
#include <stdint.h>
#include <math.h>
#include <string.h>

__device__ __forceinline__ int lane_opq() { int l; asm volatile("v_mbcnt_lo_u32_b32 %0, -1, 0\n\tv_mbcnt_hi_u32_b32 %0, -1, %0" : "=v"(l)); return l; }
#define LDS_BARRIER() do { asm volatile("s_waitcnt lgkmcnt(0)" ::: "memory"); __builtin_amdgcn_s_barrier(); asm volatile("" ::: "memory"); } while (0)
namespace pg8 {
#define PG8_LAS __attribute__((address_space(3)))
typedef unsigned short bf16_t;
typedef short bf16x8 __attribute__((ext_vector_type(8)));
typedef float f32x4 __attribute__((ext_vector_type(4)));
typedef unsigned u32x4 __attribute__((ext_vector_type(4)));
constexpr int BM = 256, BK = 64, HALF = 128, HTB = HALF * BK * 2  , STAGE_BYTES = 8 * HTB, NXCD = 8, WGM = 8;

__host__ __device__ __forceinline__ int lds_byte(int r, int c) { const int st = (r >> 4) * 2 + (c >> 5), rr = r & 15, cc = c & 31, ob = rr * 64 + cc * 2; return st * 1024 + (ob ^ (((ob >> 9) & 1) << 5)); }
__host__ __device__ __forceinline__ void stage_rc(int b, int& R, int& C) { const int st = b / 1024, sb = b % 1024, swz = sb ^ (((sb >> 9) & 1) << 5); R = (st >> 1) * 16 + swz / 64; C = (st & 1) * 32 + (swz % 64) / 2; }
__host__ __device__ __forceinline__ int perm32(int rho) { const int n = rho >> 4, i = rho & 15; return 8 * (i >> 2) + 4 * n + (i & 3); }

struct Unit { int pm, pn, koff; };
struct Gemm { const bf16_t* A; const bf16_t* Bt; int M, N, K, ld; };

struct StaticOrder {
    int nM, nN, nwg, G, c;
    __host__ __device__ void init(int M, int N, int G_, int c_) { nM = M / BM; nN = N / BM; nwg = nM * nN; G = G_; c = c_; }
    __host__ __device__ bool next(int i, Unit& u) const {
        const long L = (long)i * G + c; if (L >= nwg) return false;
        int wgid = (int)L; { const int q = nwg / NXCD, r = nwg % NXCD, xcd = wgid % NXCD, off = wgid / NXCD; wgid = (xcd < r ? xcd * (q + 1) : r * (q + 1) + (xcd - r) * q) + off; }
        const int nig = WGM * nN, gid = wgid / nig, fm = gid * WGM, gsz = (nM - fm) < WGM ? (nM - fm) : WGM;
        u.pm = fm + ((wgid % nig) % gsz); u.pn = (wgid % nig) / gsz; u.koff = 0; return true;
    }
    __device__ __forceinline__ void a_ready(const Unit&) const {}
    __device__ __forceinline__ void done(const Unit&) const {}
};
struct SplitKOrder {
    int nN, nS, nwg, G, c, ksb;
    __device__ void init(int M, int N, int nS_, int kslice, int G_, int c_) { nN = N / BM; nS = nS_; nwg = (M / BM) * nN * nS; G = G_; c = c_; ksb = kslice * 2; }
    __device__ bool next(int i, Unit& u) const { const int L = i * G + c; if (L >= nwg) return false; const int sl = L % nS, tile = L / nS; u.pn = tile % nN; u.pm = tile / nN; u.koff = sl * ksb; return true; }
    __device__ __forceinline__ void a_ready(const Unit&) const {}
    __device__ __forceinline__ void done(const Unit&) const {}
};
typedef float cvt_f2_t __attribute__((ext_vector_type(2))); typedef __bf16 cvt_b2_t __attribute__((ext_vector_type(2)));
__device__ __forceinline__ unsigned cvt_pk_bf16(float lo, float hi) { const cvt_f2_t v = {lo, hi}; return __builtin_bit_cast(unsigned, __builtin_convertvector(v, cvt_b2_t)); }

template <class Epi, class Sched, bool STAMP = false>
__device__ __forceinline__ void gemm_phase(PG8_LAS unsigned char* lds, const Gemm g, const Sched& S, const Epi& E, unsigned long long* stamps, int wv) {
    int tid = wv * 64 + lane_opq(); asm volatile("" : "+v"(tid));
    const int wid = __builtin_amdgcn_readfirstlane(tid >> 6), lane = tid & 63, wr = wid >> 2, wc = wid & 3, fr = lane & 15, fq = lane >> 4;
    const int K = g.K, nt = K / BK, ld = g.ld;
    int ts_lo = 0, ts_hi = 0, nts = 0; const unsigned long long rt_entry = STAMP ? (unsigned long long)wall_clock64() : 0ull;
#define PG8_STAMP() do { if (STAMP && wid == 0 && nts < 64) { const unsigned long long _c = (unsigned long long)clock64(); \
        ts_lo = (lane == nts) ? (int)(unsigned)_c : ts_lo; ts_hi = (lane == nts) ? (int)(unsigned)(_c >> 32) : ts_hi; ++nts; } } while (0)
    PG8_STAMP();
    unsigned voffA[2], voffB[2];
#pragma unroll
    for (int i = 0; i < 2; ++i) { int R, C; stage_rc(tid * 16 + i * 8192, R, C); const int Rb = Epi::PERM ? ((R & ~31) + perm32(R & 31)) : R;
        voffA[i] = (unsigned)(R * ld + C) * 2u; voffB[i] = (unsigned)(Rb * ld + C) * 2u; }
    const size_t kstep = (size_t)(BK * 2);
    const size_t hstep = (size_t)HALF * ld * 2;
    const size_t tstep = 2 * hstep;
    const unsigned ldsw = (unsigned)wid * 1024u;
    const int aoff = lds_byte(wr * 64 + fr, fq * 8), boff = lds_byte(wc * 32 + fr, fq * 8);
#define PG8_SA(b, h) (((b) * 2 + (h)) * HTB)
#define PG8_SB(b, h) ((4 + (b) * 2 + (h)) * HTB)
#define PG8_STAGE(bufoff, gbase, voff) do { _Pragma("unroll") for (int _i = 0; _i < 2; ++_i) \
        __builtin_amdgcn_global_load_lds((const unsigned*)((const char*)(gbase) + (voff)[_i]), (PG8_LAS unsigned*)(lds + (bufoff) + ldsw + _i * 8192), 16, 0, 0); } while (0)
#define PG8_LDA(dst, b, h) do { _Pragma("unroll") for (int m = 0; m < 4; ++m) _Pragma("unroll") for (int k = 0; k < 2; ++k) dst[m][k] = *(const PG8_LAS bf16x8*)(lds + PG8_SA(b, h) + aoff + m * 2048 + k * 1024); } while (0)
#define PG8_LDB(dst, b, h) do { _Pragma("unroll") for (int n = 0; n < 2; ++n) _Pragma("unroll") for (int k = 0; k < 2; ++k) dst[n][k] = *(const PG8_LAS bf16x8*)(lds + PG8_SB(b, h) + boff + n * 2048 + k * 1024); } while (0)
#define PG8_MMA(ai, bj, At, Bt) do { __builtin_amdgcn_s_setprio(1); _Pragma("unroll") for (int m = 0; m < 4; ++m) _Pragma("unroll") for (int n = 0; n < 2; ++n) _Pragma("unroll") for (int k = 0; k < 2; ++k) \
        acc[ai][bj][m][n] = __builtin_amdgcn_mfma_f32_16x16x32_bf16(Bt[n][k], At[m][k], acc[ai][bj][m][n], 0, 0, 0); __builtin_amdgcn_s_setprio(0); } while (0)
#define PG8_WAIT_V(n) asm volatile("s_waitcnt vmcnt(" #n ")" ::: "memory")
#define PG8_WAIT_L(n) asm volatile("s_waitcnt lgkmcnt(" #n ")" ::: "memory")
#define PG8_BAR __builtin_amdgcn_s_barrier()
#define PG8_SCHED __builtin_amdgcn_sched_barrier(0)
    Unit cur, nxt; int ui = 0;
    if (!S.next(0, cur)) return;
    f32x4 acc[2][2][4][2];
#pragma unroll
    for (int a = 0; a < 2; ++a)
#pragma unroll
        for (int b = 0; b < 2; ++b)
#pragma unroll
            for (int m = 0; m < 4; ++m)
#pragma unroll
                for (int n = 0; n < 2; ++n) acc[a][b][m][n] = (f32x4){0.f, 0.f, 0.f, 0.f};
    bf16x8 At[4][2], B0[2][2], B1[2][2];
    const char* cA = (const char*)g.A + (size_t)cur.pm * tstep + cur.koff; const char* cB = (const char*)g.Bt + (size_t)cur.pn * tstep + cur.koff;
    S.a_ready(cur);
    PG8_STAGE(PG8_SB(0, 0), cB, voffB); PG8_STAGE(PG8_SA(0, 0), cA, voffA); PG8_STAGE(PG8_SB(0, 1), cB + hstep, voffB); PG8_STAGE(PG8_SA(0, 1), cA + hstep, voffA);
    if (wr == 1) PG8_BAR;
    PG8_WAIT_V(4); PG8_BAR;
    PG8_STAGE(PG8_SB(1, 0), cB + kstep, voffB); PG8_STAGE(PG8_SA(1, 0), cA + kstep, voffA); PG8_STAGE(PG8_SB(1, 1), cB + hstep + kstep, voffB);
    PG8_WAIT_V(6); PG8_BAR;
    PG8_STAMP();
    for (;;) {
        const bool has_next = S.next(ui + 1, nxt);
        const char* nA = has_next ? (const char*)g.A + (size_t)nxt.pm * tstep + nxt.koff : cA; const char* nB = has_next ? (const char*)g.Bt + (size_t)nxt.pn * tstep + nxt.koff : cB;
        for (int t = 0; t < nt; t += 2) {
            const bool last = (t == nt - 2);
            const char* a1 = cA + (size_t)(t + 1) * kstep;
            const char* a2 = last ? nA : cA + (size_t)(t + 2) * kstep; const char* b2 = last ? nB : cB + (size_t)(t + 2) * kstep;
            const char* a3 = a2 + kstep; const char* b3 = b2 + kstep;
            if (last && has_next) S.a_ready(nxt);
            PG8_LDB(B0, 0, 0); PG8_SCHED; PG8_LDA(At, 0, 0); PG8_STAGE(PG8_SA(1, 1), a1 + hstep, voffA);
            PG8_WAIT_L(8); PG8_BAR; PG8_WAIT_L(0); PG8_MMA(0, 0, At, B0); PG8_BAR; PG8_SCHED;
            PG8_LDB(B1, 0, 1); PG8_STAGE(PG8_SB(0, 0), b2, voffB);
            PG8_BAR; PG8_WAIT_L(0); PG8_MMA(0, 1, At, B1); PG8_BAR;
            PG8_LDA(At, 0, 1); PG8_STAGE(PG8_SA(0, 0), a2, voffA);
            PG8_BAR; PG8_WAIT_L(0); PG8_MMA(1, 0, At, B0); PG8_BAR; PG8_SCHED;
            PG8_STAGE(PG8_SB(0, 1), b2 + hstep, voffB);
            PG8_WAIT_V(6); PG8_BAR; PG8_MMA(1, 1, At, B1); PG8_BAR;
            PG8_LDB(B0, 1, 0); PG8_SCHED; PG8_LDA(At, 1, 0); PG8_STAGE(PG8_SA(0, 1), a2 + hstep, voffA);
            PG8_WAIT_L(8); PG8_BAR; PG8_WAIT_L(0); PG8_MMA(0, 0, At, B0); PG8_BAR; PG8_SCHED;
            PG8_LDB(B1, 1, 1); PG8_STAGE(PG8_SB(1, 0), b3, voffB);
            PG8_BAR; PG8_WAIT_L(0); PG8_MMA(0, 1, At, B1); PG8_BAR;
            PG8_LDA(At, 1, 1); PG8_STAGE(PG8_SA(1, 0), a3, voffA);
            PG8_BAR; PG8_WAIT_L(0); PG8_MMA(1, 0, At, B0); PG8_BAR; PG8_SCHED;
            PG8_STAGE(PG8_SB(1, 1), b3 + hstep, voffB);
            PG8_WAIT_V(6); PG8_BAR; PG8_MMA(1, 1, At, B1); PG8_BAR;
        }
        PG8_STAMP();
        if constexpr (!Epi::AFTER_DRAIN) { E(acc, cur, wr, wc, fr, fq); S.done(cur); }
        PG8_STAMP();
        if (!has_next) break;
#pragma unroll
        for (int a = 0; a < 2; ++a)
#pragma unroll
            for (int b = 0; b < 2; ++b)
#pragma unroll
                for (int m = 0; m < 4; ++m)
#pragma unroll
                    for (int n = 0; n < 2; ++n) acc[a][b][m][n] = (f32x4){0.f, 0.f, 0.f, 0.f};
        cur = nxt; cA = nA; cB = nB; ++ui;
    }
    PG8_WAIT_V(0);
    if (wr == 0) PG8_BAR;
    PG8_BAR;
    if constexpr (Epi::AFTER_DRAIN) { E.fused(acc, cur, wr, wc, fr, fq, lds, wid, lane); S.done(cur); }
    PG8_STAMP();
    if (STAMP && wid == 0) { stamps[lane] = lane < nts ? (((unsigned long long)(unsigned)ts_hi << 32) | (unsigned)ts_lo) : 0ull;
        if (lane == 62) stamps[62] = rt_entry; if (lane == 63) stamps[63] = (unsigned long long)wall_clock64(); }
#undef PG8_STAMP
#undef PG8_SA
#undef PG8_SB
#undef PG8_STAGE
#undef PG8_LDA
#undef PG8_LDB
#undef PG8_MMA
#undef PG8_WAIT_V
#undef PG8_WAIT_L
#undef PG8_BAR
#undef PG8_SCHED
}
}

#define XB_TMO      128
#define XB_XCNT(j)  (256  + 64 * (j))
#define XB_XSUB(j)  (1280 + 64 * (j))
#define XB_XGEN(j)  (2304 + 64 * (j))
#define XB_TOP      3328
#define XB_TOPGEN   3392
#define XCD_BAR_WORDS 3456
#define XB_SPIN_CAP (1u << 22)
#define LAS __attribute__((address_space(3)))

__device__ __forceinline__ unsigned xb_ld(unsigned* p)              { return __hip_atomic_load(p, __ATOMIC_RELAXED, __HIP_MEMORY_SCOPE_AGENT); }
__device__ __forceinline__ unsigned xb_add(unsigned* p, unsigned v) { return __hip_atomic_fetch_add(p, v, __ATOMIC_RELAXED, __HIP_MEMORY_SCOPE_AGENT); }
__device__ __forceinline__ unsigned xb_xcc_id() { return (unsigned)__builtin_amdgcn_s_getreg((3 << 11) | 20) & 0xFu; }
#define XB_SPIN(cond, bar) do { unsigned _sp = 0; while (cond) { __builtin_amdgcn_s_sleep(1); \
    if ((++_sp & 255u) == 0u) { if (xb_ld(&(bar)[XB_TMO])) break; if (_sp > XB_SPIN_CAP) { atomicAdd(&(bar)[XB_TMO], 1u); break; } } } } while (0)

struct XcdBarrier {
    unsigned* bar; unsigned x;
    volatile LAS unsigned* st;
};

__device__ __forceinline__ XcdBarrier xcd_barrier_post(unsigned* bar, volatile LAS unsigned* st) {
    XcdBarrier b; b.bar = bar; b.x = xb_xcc_id(); b.st = st;
    if (threadIdx.x == 0) (void)xb_add(&bar[XB_XCNT(b.x)], 1u);
    return b;
}
__device__ __forceinline__ void xcd_barrier_complete(unsigned* bar, unsigned x, unsigned& nloc, unsigned& nx) {
    const unsigned G = gridDim.x * gridDim.y * gridDim.z;
    unsigned sum, cnt, mine, sp = 0u;
    for (;;) {
        sum = 0u; cnt = 0u; mine = 0u;
#pragma unroll
        for (unsigned j = 0; j < 16; ++j) { const unsigned c = xb_ld(&bar[XB_XCNT(j)]); sum += c; cnt += (c > 0u) ? 1u : 0u; mine = (j == x) ? c : mine; }
        if (sum == G) break;
        __builtin_amdgcn_s_sleep(1);
        if ((++sp & 255u) == 0u) { if (xb_ld(&bar[XB_TMO])) break; if (sp > XB_SPIN_CAP) { atomicAdd(&bar[XB_TMO], 1u); break; } }
    }
    nloc = mine > 0u ? mine : 1u; nx = cnt > 0u ? cnt : 1u;
}

__device__ __forceinline__ void xcd_barrier(const XcdBarrier& b, int wv) {
    asm volatile("s_waitcnt vmcnt(0)" ::: "memory");
    __syncthreads();
    if (wv * 64 + lane_opq() == 0) {
        unsigned* bar = b.bar;
        __builtin_amdgcn_s_waitcnt(0);
        unsigned nloc = b.st[0], nx = b.st[1];
        if (nloc == 0u) { xcd_barrier_complete(bar, b.x, nloc, nx); b.st[0] = nloc; b.st[1] = nx; }
        const unsigned old = xb_add(&bar[XB_XSUB(b.x)], 1u);
        const unsigned gen = old / nloc;
        if (old + 1u == (gen + 1u) * nloc) {
            __builtin_amdgcn_fence(__ATOMIC_RELEASE, "agent");
            asm volatile("s_waitcnt vmcnt(0)" ::: "memory");
            const unsigned og = xb_add(&bar[XB_TOP], 1u);
            const unsigned tg = og / nx;
            if (og + 1u == (tg + 1u) * nx) xb_add(&bar[XB_TOPGEN], 1u);
            else XB_SPIN(xb_ld(&bar[XB_TOPGEN]) == tg, bar);
            __builtin_amdgcn_fence(__ATOMIC_ACQUIRE, "agent");
            xb_add(&bar[XB_XGEN(b.x)], 1u);
            asm volatile("s_waitcnt vmcnt(0)" ::: "memory");
        } else {
            XB_SPIN(xb_ld(&bar[XB_XGEN(b.x)]) == gen, bar);
            __builtin_amdgcn_fence(__ATOMIC_ACQUIRE, "agent");
            asm volatile("s_waitcnt vmcnt(0)" ::: "memory");
        }
    }
    __syncthreads();
}


namespace {
constexpr int D = 2048, NBATCH = 2, SEQ = 4096, CTXL = 256, DEPTH = 4, DFF = 5632;
constexpr int ML = NBATCH * SEQ, MC = NBATCH * CTXL, MT = ML + MC;
constexpr int G = 128, P = 64, HG = 16;
constexpr int NMOD = 6 * D;
using pg8::bf16_t; using pg8::f32x4; using pg8::Unit;
typedef unsigned u32x2 __attribute__((ext_vector_type(2)));
__device__ __forceinline__ bf16_t f2bf(float f) { return __builtin_bit_cast(unsigned short, (__bf16)f); }
using pg8::bf16x8;
__device__ __forceinline__ float fsilu(float x) { return x * __builtin_amdgcn_rcpf(1.0f + __expf(-x)); }
__device__ __forceinline__ float fsigmoid(float x) { return __builtin_amdgcn_rcpf(1.0f + __expf(-x)); }
constexpr int GDN_PROJ = 12416, GDN_LD = 12544, GDN_CONV = 8192, GDN_V = 4096;

__device__ __forceinline__ int otid(int wv) { int t = wv * 64 + lane_opq(); asm volatile("" : "+v"(t)); return t; }
__device__ __forceinline__ unsigned char* dyn_lds() { extern __shared__ __attribute__((aligned(16))) unsigned char shm_[]; return shm_; }
__device__ __forceinline__ float silu_f(float x) { return x / (1.0f + expf(-x)); }
__device__ __forceinline__ float sigmoid_f(float x) { return 1.0f / (1.0f + expf(-x)); }
__device__ __forceinline__ float gelu_tanh_f(float x) { return 0.5f * x * (1.0f + tanhf(0.7978845608028654f * (x + 0.044715f * x * x * x))); }
__device__ __forceinline__ int stream_of(int row) { return row < ML ? row / SEQ : 2; }
__device__ __forceinline__ float wave_sum(float v) {
  int l = lane_opq(); asm volatile("" : "+v"(l));
#pragma unroll
  for (int o = 32; o > 0; o >>= 1) v += __int_as_float(__builtin_amdgcn_ds_bpermute((l ^ o) << 2, __float_as_int(v)));
  return v;
}
__device__ __forceinline__ float block_sum(float v, float* red, int tid_) {
  v = wave_sum(v);
  const int w = tid_ >> 6, nw = blockDim.x >> 6;
  __syncthreads();
  if ((tid_ & 63) == 0) red[w] = v;
  __syncthreads();
  float s = 0.f;
  for (int i = 0; i < nw; ++i) s += red[i];
  return s;
}

__device__ __forceinline__ void k_silu_vec(int wv, const float* c, const float* cctx, float* sv) {
  for (int i = blockIdx.x * blockDim.x + otid(wv); i < 3 * D; i += gridDim.x * blockDim.x)
    sv[i] = i < 2 * D ? silu_f(c[i]) : silu_f(cctx[i - 2 * D]);
}
constexpr int MOD_KS = 64, MOD_NS = D / MOD_KS;
__device__ __forceinline__ void k_mod_partial(int wv, const float* __restrict__ cvec, const float* __restrict__ cctx, const float* __restrict__ ada_w, float* __restrict__ modp) {
  const int lane = lane_opq();
  const int nwave = gridDim.x * 8, wave = wv * gridDim.x + blockIdx.x;
  for (int item = wave; item < DEPTH * MOD_NS * (NMOD / 256); item += nwave) {
    const int cc = item % (NMOD / 256), sl = (item / (NMOD / 256)) % MOD_NS, i = item / ((NMOD / 256) * MOD_NS);
    const int col = cc * 256 + lane * 4, k0 = sl * MOD_KS;
    const float* W = ada_w + ((size_t)i * D + k0) * NMOD + col;
    f32x4 a0 = {0.f, 0.f, 0.f, 0.f}, a1 = a0, a2 = a0;
    const float sv0 = silu_f(cvec[k0 + lane]), sv1 = silu_f(cvec[D + k0 + lane]), sv2 = silu_f(cctx[k0 + lane]);
#pragma unroll 8
    for (int k = 0; k < MOD_KS; ++k) { const f32x4 w = *(const f32x4*)(W + (size_t)k * NMOD);
      a0 += w * __int_as_float(__builtin_amdgcn_readlane(__float_as_int(sv0), k)); a1 += w * __int_as_float(__builtin_amdgcn_readlane(__float_as_int(sv1), k)); a2 += w * __int_as_float(__builtin_amdgcn_readlane(__float_as_int(sv2), k)); }
    float* o = modp + ((size_t)(sl * DEPTH + i) * 3) * NMOD + col;
    *(f32x4*)(o) = a0; *(f32x4*)(o + NMOD) = a1; *(f32x4*)(o + 2 * NMOD) = a2;
  }
}
__device__ __forceinline__ void k_mod_reduce(int wv, const float* __restrict__ modp, const float* __restrict__ ada_b, float* __restrict__ mod) {
  int tid_ = otid(wv);
  for (int idx = blockIdx.x * 512 + tid_; idx < DEPTH * 3 * NMOD; idx += gridDim.x * 512) {
    const int n = idx % NMOD, i = idx / (3 * NMOD);
    float a = ada_b[i * NMOD + n];
#pragma unroll 8
    for (int sl = 0; sl < MOD_NS; ++sl) a += modp[(size_t)sl * DEPTH * 3 * NMOD + idx];
    mod[idx] = a;
  }
}
struct Pend { const float* P; const float* gate; const float* bias; int nS; };
template <int NS> __device__ __forceinline__ void k_modnorm(int wv, float* src, const float* g, const float* modl, int shi, int sci, float* dst, unsigned short* dstb, int M, Pend pd) {
  const int lane = lane_opq();
  const int nwave = gridDim.x * 8, wave = wv * gridDim.x + blockIdx.x;
  for (int row = wave; row < M; row += nwave) {
    const int r = stream_of(row);
    float* x = src + (size_t)row * D + lane * 4;
    f32x4 xv[8];
#pragma unroll
    for (int q = 0; q < 8; ++q) xv[q] = *(const f32x4*)(x + 256 * q);
    if (NS > 0 && row >= ML) {
#pragma unroll
      for (int q = 0; q < 8; ++q) { f32x4 pv[NS > 0 ? NS : 1];
#pragma unroll
        for (int sl = 0; sl < NS; ++sl) pv[sl] = *(const f32x4*)(pd.P + ((size_t)sl * MC + (row - ML)) * D + lane * 4 + 256 * q);
        f32x4 a = {0.f, 0.f, 0.f, 0.f}; if (pd.bias) a = *(const f32x4*)(pd.bias + lane * 4 + 256 * q);
#pragma unroll
        for (int sl = 0; sl < NS; ++sl) a += pv[sl];
        xv[q] += *(const f32x4*)(pd.gate + lane * 4 + 256 * q) * a; *(f32x4*)(x + 256 * q) = xv[q]; }
    }
    float ss = 0.f;
#pragma unroll
    for (int q = 0; q < 8; ++q) ss += xv[q][0] * xv[q][0] + xv[q][1] * xv[q][1] + xv[q][2] * xv[q][2] + xv[q][3] * xv[q][3];
    ss = wave_sum(ss);
    const float rstd = rsqrtf(ss / D + 1e-6f);
    const float* sh = modl + (size_t)r * NMOD + shi * D + lane * 4; const float* sc = modl + (size_t)r * NMOD + sci * D + lane * 4; const float* gn = g + lane * 4;
#pragma unroll
    for (int q = 0; q < 8; ++q) { const f32x4 gv = *(const f32x4*)(gn + 256 * q), scv = *(const f32x4*)(sc + 256 * q), shv = *(const f32x4*)(sh + 256 * q);
      f32x4 h;
#pragma unroll
      for (int jj = 0; jj < 4; ++jj) h[jj] = xv[q][jj] * rstd * gv[jj] * (1.0f + scv[jj]) + shv[jj];
      if (dst) *(f32x4*)(dst + (size_t)row * D + lane * 4 + 256 * q) = h;
      if (dstb) *(u32x2*)(dstb + (size_t)row * D + lane * 4 + 256 * q) = (u32x2){pg8::cvt_pk_bf16(h[0], h[1]), pg8::cvt_pk_bf16(h[2], h[3])}; }
  }
}
__device__ __forceinline__ void k_final(int wv, const float* src, const float* g, float* dst, int M) {
  const int lane = lane_opq();
  const int nwave = gridDim.x * 8, wave = wv * gridDim.x + blockIdx.x;
  for (int row = wave; row < M; row += nwave) {
    const float* x = src + (size_t)row * D + lane * 4;
    f32x4 xv[8]; float ss = 0.f;
#pragma unroll
    for (int q = 0; q < 8; ++q) { xv[q] = *(const f32x4*)(x + 256 * q); ss += xv[q][0] * xv[q][0] + xv[q][1] * xv[q][1] + xv[q][2] * xv[q][2] + xv[q][3] * xv[q][3]; }
    ss = wave_sum(ss);
    const float rstd = rsqrtf(ss / D + 1e-6f);
#pragma unroll
    for (int q = 0; q < 8; ++q) { const f32x4 gv = *(const f32x4*)(g + lane * 4 + 256 * q); *(f32x4*)(dst + (size_t)row * D + lane * 4 + 256 * q) = xv[q] * rstd * gv; }
  }
}
__device__ __forceinline__ void k_copy_x(int wv, const float* x, const float* ctx, float* xb) {
  int tid_ = otid(wv);
  const size_t n = (size_t)MT * D;
  for (size_t i = (size_t)blockIdx.x * blockDim.x + tid_; i < n; i += (size_t)gridDim.x * blockDim.x)
    xb[i] = i < (size_t)ML * D ? x[i] : ctx[i - (size_t)ML * D];
}

__device__ __forceinline__ void k_resid(int wv, float* x, const float* y, int ldy, const float* modl, int gi, int M) {
  int tid_ = otid(wv);
  const size_t n = (size_t)M * D;
  for (size_t i = (size_t)blockIdx.x * blockDim.x + tid_; i < n; i += (size_t)gridDim.x * blockDim.x) {
    const int row = (int)(i / D), c = (int)(i % D), r = stream_of(row);
    x[i] += modl[(size_t)r * NMOD + gi * D + c] * y[(size_t)row * ldy + c];
  }
}
__device__ __forceinline__ void k_resid_glu(int wv, float* x, const float* gz, const float* modl, int gi, int M) {
  int tid_ = otid(wv);
  const size_t n = (size_t)M * D;
  for (size_t i = (size_t)blockIdx.x * blockDim.x + tid_; i < n; i += (size_t)gridDim.x * blockDim.x) {
    const int row = (int)(i / D), c = (int)(i % D), r = stream_of(row);
    const float a = gz[(size_t)row * 2 * D + c], b = gz[(size_t)row * 2 * D + D + c];
    x[i] += modl[(size_t)r * NMOD + gi * D + c] * (a * sigmoid_f(b));
  }
}
__device__ __forceinline__ void k_swiglu(int wv, const float* g, const float* u, float* act, size_t n) {
  int tid_ = otid(wv);
  for (size_t i = (size_t)blockIdx.x * blockDim.x + tid_; i < n; i += (size_t)gridDim.x * blockDim.x) act[i] = silu_f(g[i]) * u[i];
}

__device__ __forceinline__ void k_s5_scan(int wv, const float* __restrict__ h, const float* a_re, const float* a_im, const float* log_dt, const float* b_re, const float* b_im,
                          const float* c_re, const float* c_im, float* ydir, int col_major) {
  int tid_ = otid(wv);
  const int lane = tid_ & 63, wave = (tid_ >> 6) * gridDim.x + blockIdx.x, nw = (gridDim.x * blockDim.x) >> 6;
  for (int item = wave; item < NBATCH * G * 2; item += nw) {
    const int dir = item & 1, g = (item >> 1) % G, b = item / (2 * G);
    const int p = lane, gp = (dir * G + g) * P + p;
    const float are = a_re[gp], aim = a_im[gp], dt = expf(log_dt[dir * G + g]);
    const float mag = expf(are * dt), lr = mag * cosf(aim * dt), li = mag * sinf(aim * dt);
    const float nr = lr - 1.0f, ni = li, den = are * are + aim * aim;
    const float qr = (nr * are + ni * aim) / den, qi = (ni * are - nr * aim) / den;
    float Br[16], Bi[16], Cr[16], Ci[16];
#pragma unroll
    for (int c = 0; c < 16; ++c) { const float br = b_re[(size_t)gp * 16 + c], bi = b_im[(size_t)gp * 16 + c]; Br[c] = qr * br - qi * bi; Bi[c] = qr * bi + qi * br; }
#pragma unroll
    for (int i = 0; i < 16; ++i) { Cr[i] = c_re[((size_t)(dir * G + g) * 16 + i) * P + p]; Ci[i] = c_im[((size_t)(dir * G + g) * 16 + i) * P + p]; }
    float hr = 0.f, hi = 0.f;
    for (int s = 0; s < CTXL + SEQ; ++s) {
      int row;
      if (s < CTXL) { const int t = dir ? CTXL - 1 - s : s; row = ML + b * CTXL + t; }
      else { int q = s - CTXL; if (dir) q = SEQ - 1 - q; const int t = col_major ? ((q & 63) * 64 + (q >> 6)) : q; row = b * SEQ + t; }
      const float* u = h + (size_t)row * D + g * 16;
      float ur = 0.f, ui = 0.f;
#pragma unroll
      for (int c = 0; c < 16; ++c) { const float uc = u[c]; ur += Br[c] * uc; ui += Bi[c] * uc; }
      const float nhr = lr * hr - li * hi + ur, nhi = lr * hi + li * hr + ui;
      hr = nhr; hi = nhi;
      float outv = 0.f;
#pragma unroll
      for (int i = 0; i < 16; ++i) { float v = Cr[i] * hr - Ci[i] * hi; v = wave_sum(v); if (lane == i) outv = v; }
      if (lane < 16) ydir[((size_t)dir * MT + row) * D + g * 16 + lane] = outv;
    }
  }
}
__device__ __forceinline__ void k_s5_gelu(int wv, const float* h, const float* dvec, const float* ydir, unsigned short* z) {
  int tid_ = otid(wv);
  const size_t n = (size_t)MT * D;
  for (size_t i = (size_t)blockIdx.x * blockDim.x + tid_; i < n; i += (size_t)gridDim.x * blockDim.x) {
    const int c = (int)(i % D);
    const float v = gelu_tanh_f(h[i] * dvec[c] + ydir[i] + ydir[n + i]);
    unsigned uu = __float_as_uint(v); uu += 0x7FFFu + ((uu >> 16) & 1u); z[i] = (unsigned short)(uu >> 16);
  }
}

__device__ __forceinline__ double dsin_red(double x) {
  const double k = rint(x * 0.15915494309189535);
  const double r = x - k * 6.283185307179586;
  return (double)sinf((float)r);
}
__device__ __forceinline__ void k_hy_hdn(int wv, const float* w1, const float* b1, const float* w2, const float* b2, const float* w3, const float* b3, const float* freq, float* hdn3) {
  int tid_ = otid(wv);
  double (*sh)[64] = (double (*)[64])dyn_lds();
  __syncthreads();
  const int lane = tid_ & 63, wl = tid_ >> 6;
  float* W1s = (float*)(dyn_lds() + 4096); float* W2s = W1s + 33 * 64; float* W3s = W2s + 64 * 64;
  for (int e = tid_; e < 33 * 64; e += 512) W1s[e] = w1[e];
  for (int e = tid_; e < 64 * 64; e += 512) { W2s[e] = w2[e]; W3s[e] = w3[e]; }
  __syncthreads();
  for (int tb = blockIdx.x * 8; tb < SEQ + CTXL; tb += gridDim.x * 8) {
    const int tt = tb + wl;
    const int n = tt < SEQ ? SEQ : CTXL, t = tt < SEQ ? tt : tt - SEQ;
    const double t_unit = (double)t / (double)(n - 1);
    const double fq = (double)freq[lane];
    double a = (double)b1[lane] + t_unit * (double)W1s[lane];
#pragma unroll
    for (int kb = 0; kb < 16; ++kb) {
      const double band = 1e-4 + (15.0 - 1e-4) * (double)kb / 15.0;
      double fr = (double)t * band / (double)n; fr -= floor(fr);
      const float ang = (float)(2.0 * M_PI * fr);
      a += (double)cosf(ang) * (double)W1s[(1 + kb) * 64 + lane] - (double)sinf(ang) * (double)W1s[(17 + kb) * 64 + lane];
    }
    double hcur = dsin_red(fq * a);
    sh[wl][lane] = hcur; __syncthreads();
    a = (double)b2[lane];
    { double a1 = 0.0, a2 = 0.0, a3 = 0.0;
#pragma unroll
      for (int e = 0; e < 64; e += 4) { a += sh[wl][e] * (double)W2s[(e) * 64 + lane]; a1 += sh[wl][e + 1] * (double)W2s[(e + 1) * 64 + lane]; a2 += sh[wl][e + 2] * (double)W2s[(e + 2) * 64 + lane]; a3 += sh[wl][e + 3] * (double)W2s[(e + 3) * 64 + lane]; }
      a = (a + a1) + (a2 + a3); }
    hcur = dsin_red(fq * a);
    __syncthreads(); sh[wl][lane] = hcur; __syncthreads();
    a = (double)b3[lane];
    { double a1 = 0.0, a2 = 0.0, a3 = 0.0;
#pragma unroll
      for (int e = 0; e < 64; e += 4) { a += sh[wl][e] * (double)W3s[(e) * 64 + lane]; a1 += sh[wl][e + 1] * (double)W3s[(e + 1) * 64 + lane]; a2 += sh[wl][e + 2] * (double)W3s[(e + 2) * 64 + lane]; a3 += sh[wl][e + 3] * (double)W3s[(e + 3) * 64 + lane]; }
      a = (a + a1) + (a2 + a3); }
    hcur = dsin_red(fq * a);
    __syncthreads();
    { const float hf = (float)hcur; const bf16_t hi = f2bf(hf); const bf16_t lo = f2bf(hf - __uint_as_float(((unsigned)hi) << 16));
      bf16_t* o = (bf16_t*)hdn3 + (size_t)tt * 256; o[lane] = hi; o[64 + lane] = hi; o[128 + lane] = lo; o[192 + lane] = 0; }
  }
}
__device__ __forceinline__ void k_hy_w4prep(int wv, const float* __restrict__ w4, bf16_t* __restrict__ W4s) {
  int tid_ = otid(wv);
  for (int e = blockIdx.x * 512 + tid_; e < 8192 * 64; e += gridDim.x * 512) { const int col = e & 8191, m = e >> 13;
    const float w = w4[(size_t)m * 8192 + col]; const bf16_t hi = f2bf(w); const bf16_t lo = f2bf(w - __uint_as_float(((unsigned)hi) << 16));
    bf16_t* o = W4s + (size_t)col * 256; o[m] = hi; o[64 + m] = lo; o[128 + m] = hi; o[192 + m] = 0; }
}
__device__ __forceinline__ void k_hy_fnorm(int wv, const float* raw, float* fnorm) {
  int tid_ = otid(wv);
  for (int idx = blockIdx.x * blockDim.x + tid_; idx < 2 * 2 * D; idx += gridDim.x * blockDim.x) {
  const int c = idx % D, o = (idx / D) % 2, ns = idx / (2 * D);
  const int n = ns ? CTXL : SEQ, toff = ns ? SEQ : 0;
  float s = 0.f;
  for (int t = 0; t < n; ++t) s += fabsf(raw[(size_t)(toff + t) * 8192 + o * 4096 + c]);
  for (int t = 1; t < n; ++t) s += fabsf(raw[(size_t)(toff + t) * 8192 + o * 4096 + 2048 + c]);
  fnorm[idx] = s;
  }
}
__device__ __forceinline__ void k_hy_dwconv(int wv, const float* u, const float* cw, const float* cb, float* uc) {
  int tid_ = otid(wv);
  const size_t n = (size_t)MT * 3 * D;
  for (size_t i = (size_t)blockIdx.x * blockDim.x + tid_; i < n; i += (size_t)gridDim.x * blockDim.x) {
    const int row = (int)(i / (3 * D)), col = (int)(i % (3 * D));
    int t, len;
    if (row < ML) { t = row % SEQ; len = SEQ; } else { t = (row - ML) % CTXL; len = CTXL; }
    float a = cb[col];
#pragma unroll
    for (int k = 0; k < 3; ++k) { const int tt = t + k - 1; if (tt >= 0 && tt < len) a += u[(size_t)(row + k - 1) * 3 * D + col] * cw[k * 3 * D + col]; }
    uc[i] = a;
  }
}
__device__ __forceinline__ void k_hy_conv(int wv, const float* zin, int ldz, const float* xk, int ldx, const float* raw, const float* fnorm, const float* bias, int o, float* zout, int ldo) {
  int tid_ = otid(wv);
  const size_t n = (size_t)MT * D;
  for (size_t i = (size_t)blockIdx.x * blockDim.x + tid_; i < n; i += (size_t)gridDim.x * blockDim.x) {
    const int row = (int)(i / D), c = (int)(i % D);
    int t, len, base, toff, ns;
    if (row < ML) { t = row % SEQ; len = SEQ; base = row - t; toff = 0; ns = 0; } else { t = (row - ML) % CTXL; len = CTXL; base = row - t; toff = SEQ; ns = 1; }
    const float* f0 = raw + (size_t)toff * 8192 + o * 4096 + c;
    const float* f1 = f0 + 2048;
    float a = 0.f;
    for (int s = 0; s <= t; ++s) a += zin[(size_t)(base + s) * ldz + c] * f0[(size_t)(t - s) * 8192];
    for (int s = t + 1; s < len; ++s) a += zin[(size_t)(base + s) * ldz + c] * f1[(size_t)(s - t) * 8192];
    const float y = a / fnorm[(ns * 2 + o) * D + c] + zin[(size_t)row * ldz + c] * bias[o * D + c];
    zout[(size_t)row * ldo + c] = xk[(size_t)row * ldx + c] * y;
  }
}


#define FD __device__ __forceinline__
#define HWSIN(f) __builtin_amdgcn_sinf(f)
#define HWCOS(f) __builtin_amdgcn_cosf(f)
typedef float c2 __attribute__((ext_vector_type(2)));
FD c2 cmul(c2 a, c2 b) { const c2 t = {-b.y, b.x}; return a.xx * b + a.yy * t; }
FD int pidx(int i) { return i + (i >> 4); }
template <bool INV> FD void dft4(c2& a, c2& b, c2& c, c2& d) {
  const c2 s0 = a + c, s1 = a - c, s2 = b + d, s3 = b - d;
  a = s0 + s2;
  c = s0 - s2;
  const c2 r = {s3.y, -s3.x};
  const c2 m = s1 + r, p = s1 - r;
  if (INV) { b = p; d = m; } else { b = m; d = p; }
}
template <bool INV> FD void dft16(c2 (&v)[16]) {
  c2 w[16];
#pragma unroll
  for (int j = 0; j < 4; ++j) {
    c2 a = v[j], b = v[j + 4], c = v[j + 8], d = v[j + 12];
    dft4<INV>(a, b, c, d);
    w[4 * j + 0] = a; w[4 * j + 1] = b; w[4 * j + 2] = c; w[4 * j + 3] = d;
  }
  const float C1 = 0.92387953251128674f, S1 = 0.38268343236508977f, C2 = 0.70710678118654752f;
#pragma unroll
  for (int j = 0; j < 4; ++j) {
    c2 x[4];
#pragma unroll
    for (int r = 0; r < 4; ++r) {
      const int m = (r * j) & 15;
      float cr, sr;
      switch (m) { case 0: cr = 1.f; sr = 0.f; break; case 1: cr = C1; sr = S1; break; case 2: cr = C2; sr = C2; break; case 3: cr = S1; sr = C1; break;
                   case 4: cr = 0.f; sr = 1.f; break; case 6: cr = -C2; sr = C2; break; default:   cr = -C1; sr = -S1; break; }
      const c2 tw = {cr, INV ? sr : -sr};
      x[r] = (m == 0) ? w[j + 4 * r] : cmul(w[j + 4 * r], tw);
    }
    dft4<INV>(x[0], x[1], x[2], x[3]);
    v[j] = x[0]; v[j + 4] = x[1]; v[j + 8] = x[2]; v[j + 12] = x[3];
  }
}
template <int N, bool INV, bool ZP = false> FD void r16_load(const c2* buf, int t, int Ns, c2 (&v)[16]) {
#pragma unroll
  for (int r = 0; r < 16; ++r) { if (ZP && r >= 8 && Ns == 1) v[r] = {0.f, 0.f}; else v[r] = buf[pidx(t + r * (N / 16))]; }
  if (Ns > 1) {
    const int k = t & (Ns - 1);
    const float base = (float)k * (1.0f / (float)(Ns * 16));
    const c2 tw1 = {HWCOS(base), INV ? HWSIN(base) : -HWSIN(base)};
    c2 tw = tw1;
#pragma unroll
    for (int r = 1; r < 16; ++r) { v[r] = cmul(v[r], tw); tw = cmul(tw, tw1); }
  }
  dft16<INV>(v);
}
template <int N> FD void r16_store(c2* buf, int t, int Ns, const c2 (&v)[16]) {
  const int k = t & (Ns - 1), j0 = (t - k) * 16 + k;
#pragma unroll
  for (int r = 0; r < 16; ++r) buf[pidx(j0 + r * Ns)] = v[r];
}
template <int N, bool INV, bool HALF = false> FD void r2_last(c2* buf, int t) {
#pragma unroll
  for (int m = 0; m < 8; ++m) {
    const int j = t + m * (N / 16);
    const float f = (float)j * (1.0f / (float)N);
    const c2 tw = {HWCOS(f), INV ? HWSIN(f) : -HWSIN(f)};
    const c2 a = buf[pidx(j)], b = cmul(buf[pidx(j + N / 2)], tw);
    buf[pidx(j)] = {a.x + b.x, a.y + b.y}; if (!HALF) buf[pidx(j + N / 2)] = {a.x - b.x, a.y - b.y};
  }
}

#undef FD
typedef __attribute__((address_space(3))) c2 lc2;
template <int N, bool INV, int MODE = 0> __device__ __forceinline__ void fft_lds(c2* buf, int tid) {
  constexpr int T = N / 16;
  asm volatile("" : "+v"(tid));
#pragma unroll
  for (int Ns = 1; Ns * 16 <= N / 2; Ns *= 16) {
    c2 v[16];
    if (tid < T) r16_load<N, INV, MODE == 1>(buf, tid, Ns, v);
    LDS_BARRIER();
    if (tid < T) r16_store<N>(buf, tid, Ns, v);
    LDS_BARRIER();
  }
  if (tid < T) r2_last<N, INV, MODE == 2>(buf, tid);
  LDS_BARRIER();
}
constexpr int HY_RAW_LD = SEQ + CTXL;
template <int N> __device__ __forceinline__ void hy_conv_chan(int tid_in, int c, const float* __restrict__ uT, const float* __restrict__ rawT, const float* __restrict__ conv_w,
                                                              const float* __restrict__ conv_b, const float* __restrict__ hy_bias, float* __restrict__ zT, c2* sig, c2* fil, float* red) {
  constexpr int n = N / 2, tt0 = (N == 2 * SEQ) ? 0 : SEQ, tok0 = (N == 2 * SEQ) ? 0 : ML, EPT = (n + 511) / 512;
  int tid = tid_in;
#define OPQ_TID() asm volatile("" : "+v"(tid))
  OPQ_TID();
  const float* r00 = rawT + (size_t)(0 * 4096 + 0 * 2048 + c) * HY_RAW_LD + tt0;
  const float* r01 = rawT + (size_t)(0 * 4096 + 1 * 2048 + c) * HY_RAW_LD + tt0;
  const float* r10 = rawT + (size_t)(1 * 4096 + 0 * 2048 + c) * HY_RAW_LD + tt0;
  const float* r11 = rawT + (size_t)(1 * 4096 + 1 * 2048 + c) * HY_RAW_LD + tt0;
  float a0 = 0.f, a1 = 0.f;
  if constexpr (n >= 512) {
    constexpr int NH = n / 512;
    float f0[NH], f1[NH], g0[NH], g1[NH];
    const float* q01 = r01 + n - tid; const float* q11 = r11 + n - tid;
#pragma unroll
    for (int m = 0; m < NH; ++m) { f0[m] = r00[tid + 512 * m]; f1[m] = r10[tid + 512 * m]; }
#pragma unroll
    for (int m = 0; m < NH; ++m) { g0[m] = q01[-512 * m]; g1[m] = q11[-512 * m]; }
#pragma unroll
    for (int m = 0; m < NH; ++m) { const int l = tid + 512 * m; fil[pidx(l)] = {f0[m], f1[m]}; a0 += fabsf(f0[m]); a1 += fabsf(f1[m]);
      const bool z = (m == 0) && (tid == 0); const float x0 = z ? 0.f : g0[m], x1 = z ? 0.f : g1[m];
      fil[pidx(n + l)] = {x0, x1}; a0 += fabsf(x0); a1 += fabsf(x1); }
  } else {
    const int l = tid;
    float k0, k1;
    if (l < n) { k0 = r00[l]; k1 = r10[l]; } else if (l == n) { k0 = 0.f; k1 = 0.f; } else { k0 = r01[N - l]; k1 = r11[N - l]; }
    fil[pidx(l)] = {k0, k1}; a0 += fabsf(k0); a1 += fabsf(k1);
  }
  a0 = block_sum(a0, red, tid); a1 = block_sum(a1, red, tid);
  const float inv0 = 1.0f / (a0 * (float)N), inv1 = 1.0f / (a1 * (float)N);
  LDS_BARRIER();
  const float b0 = hy_bias[c], b1 = hy_bias[D + c];
  struct Raw { float l0[EPT], m0[EPT], r0[EPT], l1[EPT], m1[EPT], r1[EPT]; };
  auto load_raw = [&](int ch, Raw& R) {
    const float* p0 = uT + (size_t)ch * MT + tok0 + tid; const float* p1 = p0 + n;
#pragma unroll
    for (int m = 0; m < EPT; ++m) { R.l0[m] = p0[512 * m - 1]; R.m0[m] = p0[512 * m]; R.r0[m] = p0[512 * m + 1]; R.l1[m] = p1[512 * m - 1]; R.m1[m] = p1[512 * m]; R.r1[m] = p1[512 * m + 1]; }
  };
  auto conv_raw = [&](int ch, const Raw& R, c2 (&out)[EPT]) {
    const float w0 = conv_w[ch], w1 = conv_w[1 * 3 * D + ch], w2 = conv_w[2 * 3 * D + ch], cb = conv_b[ch];
#pragma unroll
    for (int m = 0; m < EPT; ++m) { const int t = tid + 512 * m; const bool hl = t > 0, hr = t < n - 1;
      out[m] = {cb + R.m0[m] * w1 + (hl ? R.l0[m] : 0.f) * w0 + (hr ? R.r0[m] : 0.f) * w2, cb + R.m1[m] * w1 + (hl ? R.l1[m] : 0.f) * w0 + (hr ? R.r1[m] : 0.f) * w2}; }
  };
  typedef __fp16 h2 __attribute__((ext_vector_type(2)));
  h2 vch[EPT], z1h[EPT];
  {
    Raw rv; load_raw(c, rv);
    fft_lds<N, false>(fil, tid);
    OPQ_TID();
    c2 vc[EPT]; conv_raw(c, rv, vc);
#pragma unroll
    for (int m = 0; m < EPT; ++m) { const int t = tid + 512 * m; vch[m] = __builtin_amdgcn_cvt_pkrtz(vc[m].x, vc[m].y); if (t < n) { sig[pidx(t)] = vc[m]; } }
  }
  {
    Raw rx; load_raw(D + c, rx);
    LDS_BARRIER();
    fft_lds<N, false, 1>(sig, tid);
    OPQ_TID();
    for (int f = tid; f < N; f += 512) { const c2 Z = fil[pidx(f)], Zc = fil[pidx((N - f) & (N - 1))];
      const c2 K0 = {0.5f * (Z.x + Zc.x) * inv0, 0.5f * (Z.y - Zc.y) * inv0}; sig[pidx(f)] = cmul(sig[pidx(f)], K0); }
    LDS_BARRIER();
    fft_lds<N, true, 2>(sig, tid);
    OPQ_TID();
    c2 x1[EPT]; conv_raw(D + c, rx, x1);
    c2 z1[EPT];
#pragma unroll
    for (int m = 0; m < EPT; ++m) { const int t = tid + 512 * m; const c2 y = sig[pidx(t < n ? t : 0)]; z1[m] = {x1[m].x * (y.x + (float)vch[m][0] * b0), x1[m].y * (y.y + (float)vch[m][1] * b0)}; z1h[m] = __builtin_amdgcn_cvt_pkrtz(z1[m].x, z1[m].y); }
    LDS_BARRIER();
#pragma unroll
    for (int m = 0; m < EPT; ++m) { const int t = tid + 512 * m; if (t < n) { sig[pidx(t)] = z1[m]; } }
  }
  {
    Raw rx; load_raw(2 * D + c, rx);
    LDS_BARRIER();
    fft_lds<N, false, 1>(sig, tid);
    OPQ_TID();
    for (int f = tid; f < N; f += 512) { const c2 Z = fil[pidx(f)], Zc = fil[pidx((N - f) & (N - 1))];
      const c2 K1 = {0.5f * (Z.y + Zc.y) * inv1, -0.5f * (Z.x - Zc.x) * inv1}; sig[pidx(f)] = cmul(sig[pidx(f)], K1); }
    LDS_BARRIER();
    fft_lds<N, true, 2>(sig, tid);
    OPQ_TID();
    c2 x2[EPT]; conv_raw(2 * D + c, rx, x2);
    float* za = zT + (size_t)c * MT + tok0; float* zb = za + n;
#pragma unroll
    for (int m = 0; m < EPT; ++m) { const int t = tid + 512 * m;
      if (t < n) { const c2 y = sig[pidx(t)]; za[t] = x2[m].x * (y.x + (float)z1h[m][0] * b1); zb[t] = x2[m].y * (y.y + (float)z1h[m][1] * b1); } }
  }
  LDS_BARRIER();
#undef OPQ_TID
}
constexpr int FFT_BUF_BYTES = (2 * SEQ + 2 * SEQ / 16) * 8;
__device__ __forceinline__ void hy_ctx_direct(int wv, int lane, int c, const float* __restrict__ uT, const float* __restrict__ rawT, const float* __restrict__ conv_w,
                                              const float* __restrict__ conv_b, const float* __restrict__ hy_bias, float* __restrict__ zT) {
  constexpr int n = CTXL;
  float* F = (float*)(dyn_lds() + wv * 8192); c2* Z = (c2*)(F + 1024);
  float fv[2][8]; float nrm0 = 0.f, nrm1 = 0.f;
#pragma unroll
  for (int o = 0; o < 2; ++o) { const float* rf = rawT + (size_t)(o * 4096 + c) * HY_RAW_LD + SEQ; const float* rb = rawT + (size_t)(o * 4096 + 2048 + c) * HY_RAW_LD + SEQ;
#pragma unroll
    for (int k = 0; k < 8; ++k) { const int L = lane + 64 * k, lag = L - 256; const int idx = lag >= 0 ? lag : -lag; const float x = (lag >= 0 ? rf : rb)[idx]; fv[o][k] = (L == 0) ? 0.f : x; } }
#pragma unroll
  for (int k = 0; k < 8; ++k) { nrm0 += fabsf(fv[0][k]); nrm1 += fabsf(fv[1][k]); }
  nrm0 = wave_sum(nrm0); nrm1 = wave_sum(nrm1);
  const float in0 = 1.0f / nrm0, in1 = 1.0f / nrm1;
#pragma unroll
  for (int k = 0; k < 8; ++k) { F[lane + 64 * k] = fv[0][k] * in0; F[512 + lane + 64 * k] = fv[1][k] * in1; }
  c2 vc[4], x1c[4], x2c[4];
#pragma unroll
  for (int part = 0; part < 3; ++part) { const int ch = part * D + c; const float* p0 = uT + (size_t)ch * MT + ML + lane; const float* p1 = p0 + n;
    const float w0 = conv_w[ch], w1 = conv_w[3 * D + ch], w2 = conv_w[2 * 3 * D + ch], cb = conv_b[ch];
#pragma unroll
    for (int k = 0; k < 4; ++k) { const int t = lane + 64 * k; const bool hl = t > 0, hr = t < n - 1;
      const float l0 = p0[64 * k - 1], m0 = p0[64 * k], r0 = p0[64 * k + 1], l1 = p1[64 * k - 1], m1 = p1[64 * k], r1 = p1[64 * k + 1];
      const c2 o = {cb + m0 * w1 + (hl ? l0 : 0.f) * w0 + (hr ? r0 : 0.f) * w2, cb + m1 * w1 + (hl ? l1 : 0.f) * w0 + (hr ? r1 : 0.f) * w2};
      if (part == 0) vc[k] = o; else if (part == 1) x1c[k] = o; else x2c[k] = o; } }
  const float b0 = hy_bias[c], b1 = hy_bias[D + c];
#pragma unroll
  for (int k = 0; k < 4; ++k) Z[lane + 64 * k] = vc[k];
  c2 z1[4];
#pragma unroll
  for (int o = 0; o < 2; ++o) {
    asm volatile("s_waitcnt lgkmcnt(0)" ::: "memory");
    c2 acc[4] = {{0.f, 0.f}, {0.f, 0.f}, {0.f, 0.f}, {0.f, 0.f}};
    const float* Fo = F + o * 512 + 256 + lane;
    for (int s2 = 0; s2 < n; ++s2) { const c2 z = Z[s2];
#pragma unroll
      for (int k = 0; k < 4; ++k) { const float f = Fo[64 * k - s2]; acc[k].x += z.x * f; acc[k].y += z.y * f; } }
    if (o == 0) {
#pragma unroll
      for (int k = 0; k < 4; ++k) z1[k] = {x1c[k].x * (acc[k].x + vc[k].x * b0), x1c[k].y * (acc[k].y + vc[k].y * b0)};
      asm volatile("s_waitcnt lgkmcnt(0)" ::: "memory");
#pragma unroll
      for (int k = 0; k < 4; ++k) Z[lane + 64 * k] = z1[k];
    } else {
      float* za = zT + (size_t)c * MT + ML; float* zb = za + n;
#pragma unroll
      for (int k = 0; k < 4; ++k) { const int t = lane + 64 * k; za[t] = x2c[k].x * (acc[k].x + z1[k].x * b1); zb[t] = x2c[k].y * (acc[k].y + z1[k].y * b1); }
    }
  }
}
__device__ __forceinline__ void k_hy_fftconv(int wv, const float* uT, const float* rawT, const float* conv_w, const float* conv_b, const float* hy_bias, float* zT) {
  int tid_ = otid(wv);
  c2* sig = (c2*)dyn_lds(); c2* fil = (c2*)(dyn_lds() + FFT_BUF_BYTES); float* red = (float*)(dyn_lds() + 2 * FFT_BUF_BYTES);
  __syncthreads();
  for (int c = blockIdx.x; c < D; c += gridDim.x) hy_conv_chan<2 * SEQ>(tid_, c, uT, rawT, conv_w, conv_b, hy_bias, zT, sig, fil, red);
  __syncthreads();
  { const int lane = tid_ & 63; for (int c = wv * gridDim.x + blockIdx.x; c < D; c += gridDim.x * 8) hy_ctx_direct(wv, lane, c, uT, rawT, conv_w, conv_b, hy_bias, zT); }
  __syncthreads();
}
constexpr int S5_ROWS = 2 * 272, S5_T = 16;
constexpr size_t S5_SLAB = (size_t)S5_ROWS * 512 + 128;
__device__ __forceinline__ int s5_token_row(int b, int pos, int col_major) {
  if (pos < CTXL) return ML + b * CTXL + pos;
  const int q = pos - CTXL;
  return b * SEQ + (col_major ? ((q & 63) * 64 + (q >> 6)) : q);
}
struct S5W { const float *a_re, *a_im, *log_dt, *b_re, *b_im, *c_re, *c_im, *dvec; bf16_t *Pt, *TQt; };
__device__ __forceinline__ void k_s5_ops(int wv, const S5W w0, const S5W w1) {
  int tid_ = otid(wv);
  c2* lamp = (c2*)dyn_lds(); c2* Bb = lamp + 2 * 64 * 17; c2* Cc = Bb + 2 * 64 * 16; float* Kc = (float*)(Cc + 2 * 16 * 65);
  for (int item = blockIdx.x; item < 2 * G; item += gridDim.x) {
    const int g = item & (G - 1); const S5W& W = (item >> 7) ? w1 : w0;
    const float* a_re = W.a_re; const float* a_im = W.a_im; const float* log_dt = W.log_dt;
    __syncthreads();
    for (int e = tid_; e < 2 * 64 * 17; e += 512) { const int m = e % 17, p = (e / 17) % 64, d = e / (17 * 64);
      const int gp = (d * G + g) * P + p; const float dt = expf(log_dt[d * G + g]);
      const float mag = expf((float)m * a_re[gp] * dt); float sn, cs; sincosf((float)m * a_im[gp] * dt, &sn, &cs);
      lamp[e] = {mag * cs, mag * sn}; }
    for (int e = tid_; e < 2 * 64 * 16; e += 512) { const int j = e % 16, p = (e / 16) % 64, d = e / (16 * 64);
      const int gp = (d * G + g) * P + p; const float are = a_re[gp], aim = a_im[gp], dt = expf(log_dt[d * G + g]);
      const float mag = expf(are * dt); float sn, cs; sincosf(aim * dt, &sn, &cs);
      const float nr = mag * cs - 1.0f, ni = mag * sn, den = are * are + aim * aim;
      const c2 q = {(nr * are + ni * aim) / den, (ni * are - nr * aim) / den};
      const c2 bb = {W.b_re[(size_t)gp * 16 + j], W.b_im[(size_t)gp * 16 + j]};
      Bb[e] = cmul(q, bb); }
    for (int e = tid_; e < 2 * 16 * 64; e += 512) { const int p = e & 63, i = (e >> 6) & 15, d = e >> 10; const size_t src = ((size_t)(d * G + g) * 16 + i) * P + p; Cc[(d * 16 + i) * 65 + p] = {W.c_re[src], W.c_im[src]}; }
    __syncthreads();
    {
      const int i = tid_ & 15, l = (tid_ >> 4) & 15, d = tid_ >> 8;
      float acc[16];
#pragma unroll
      for (int j = 0; j < 16; ++j) acc[j] = 0.f;
#pragma unroll 2
      for (int p = 0; p < 64; ++p) { const c2 t1 = cmul(Cc[(d * 16 + i) * 65 + p], lamp[(d * 64 + p) * 17 + l]); const c2* bp = Bb + (d * 64 + p) * 16;
#pragma unroll
        for (int j = 0; j < 16; ++j) { const c2 bb = bp[j]; acc[j] += t1.x * bb.x - t1.y * bb.y; } }
#pragma unroll
      for (int j4 = 0; j4 < 4; ++j4) *(f32x4*)(Kc + tid_ * 16 + j4 * 4) = (f32x4){acc[j4 * 4], acc[j4 * 4 + 1], acc[j4 * 4 + 2], acc[j4 * 4 + 3]}; }
    __syncthreads();
    bf16_t* Pg = W.Pt + (size_t)g * 256 * 256;
    for (int e2 = tid_; e2 < 256 * 256 / 2; e2 += 512) { unsigned pk = 0;
#pragma unroll
      for (int hh = 0; hh < 2; ++hh) { const int e = e2 * 2 + hh; const int k = e & 255, col = e >> 8, s = k >> 4, j = k & 15, d = col >> 7, im = (col >> 6) & 1, p = col & 63;
        const int ex = d == 0 ? 15 - s : s;
        const c2 v = cmul(lamp[(d * 64 + p) * 17 + ex], Bb[(d * 64 + p) * 16 + j]);
        pk |= (unsigned)f2bf(im ? v.y : v.x) << (16 * hh); }
      ((unsigned*)Pg)[e2] = pk; }
    bf16_t* Tg = W.TQt + (size_t)g * 256 * 512;
    for (int e2 = tid_; e2 < 256 * 512 / 2; e2 += 512) { unsigned pk = 0;
#pragma unroll
      for (int hh = 0; hh < 2; ++hh) { const int e = e2 * 2 + hh; const int k = e & 511, n = e >> 9, t = n >> 4, i = n & 15;
        float v;
        if (k < 256) { const int s = k >> 4, j = k & 15; v = 0.f;
          if (t >= s) v += Kc[((0 * 16 + (t - s)) * 16 + i) * 16 + j];
          if (s >= t) v += Kc[((1 * 16 + (s - t)) * 16 + i) * 16 + j];
          if (s == t && i == j) v += W.dvec[g * 16 + i]; }
        else { const int kk = k - 256, d = kk >> 7, im = (kk >> 6) & 1, p = kk & 63, m = d == 0 ? t + 1 : 16 - t;
          const c2 q = cmul(Cc[(d * 16 + i) * 65 + p], lamp[(d * 64 + p) * 17 + m]); v = im ? -q.y : q.x; }
        pk |= (unsigned)f2bf(v) << (16 * hh); }
      ((unsigned*)Tg)[e2] = pk; }
  }
}
template <int NS> __device__ __forceinline__ void k_s5_modnorm(int wv, float* xb, const float* xctx_in, const float* __restrict__ gnorm, const float* __restrict__ modl, bf16_t* __restrict__ UH, int col_major, Pend pd) {
  const int lane = lane_opq();
  const int nwave = gridDim.x * 8, wave = wv * gridDim.x + blockIdx.x;
  for (int row = wave; row < MT; row += nwave) {
    const int r = stream_of(row);
    int b, pos;
    if (row < ML) { b = row / SEQ; const int t = row % SEQ; pos = CTXL + (col_major ? ((t & 63) * 64 + (t >> 6)) : t); } else { b = (row - ML) / CTXL; pos = (row - ML) % CTXL; }
    const int cc = b * 272 + (pos >> 4), s = pos & 15;
    float* x = (row >= ML && xctx_in != nullptr ? (float*)xctx_in + (size_t)(row - ML) * D : xb + (size_t)row * D) + lane * 4;
    const float* sh = modl + (size_t)r * NMOD + 0 * D + lane * 4; const float* sc = modl + (size_t)r * NMOD + 1 * D + lane * 4; const float* gn = gnorm + lane * 4;
    f32x4 xv[8], gv[8], scv[8], shv[8];
#pragma unroll
    for (int q = 0; q < 8; ++q) { xv[q] = *(const f32x4*)(x + 256 * q); gv[q] = *(const f32x4*)(gn + 256 * q); scv[q] = *(const f32x4*)(sc + 256 * q); shv[q] = *(const f32x4*)(sh + 256 * q); }
    if (NS > 0 && row >= ML) {
#pragma unroll
      for (int q = 0; q < 8; ++q) { f32x4 pv[NS > 0 ? NS : 1];
#pragma unroll
        for (int sl = 0; sl < NS; ++sl) pv[sl] = *(const f32x4*)(pd.P + ((size_t)sl * MC + (row - ML)) * D + lane * 4 + 256 * q);
        f32x4 a = {0.f, 0.f, 0.f, 0.f}; if (pd.bias) a = *(const f32x4*)(pd.bias + lane * 4 + 256 * q);
#pragma unroll
        for (int sl = 0; sl < NS; ++sl) a += pv[sl];
        xv[q] += *(const f32x4*)(pd.gate + lane * 4 + 256 * q) * a; *(f32x4*)(x + 256 * q) = xv[q]; }
    }
    float ss = 0.f;
#pragma unroll
    for (int q = 0; q < 8; ++q) ss += xv[q][0] * xv[q][0] + xv[q][1] * xv[q][1] + xv[q][2] * xv[q][2] + xv[q][3] * xv[q][3];
    ss = wave_sum(ss);
    const float rstd = rsqrtf(ss / D + 1e-6f);
#pragma unroll
    for (int q = 0; q < 8; ++q) { f32x4 h;
#pragma unroll
      for (int jj = 0; jj < 4; ++jj) h[jj] = xv[q][jj] * rstd * gv[q][jj] * (1.0f + scv[q][jj]) + shv[q][jj];
      *(u32x2*)(UH + (size_t)(16 * q + (lane >> 2)) * S5_SLAB + (size_t)cc * 512 + s * 16 + 4 * (lane & 3)) = (u32x2){pg8::cvt_pk_bf16(h[0], h[1]), pg8::cvt_pk_bf16(h[2], h[3])}; }
  }
}
__device__ __forceinline__ c2 cfma(c2 a, c2 b, c2 c) { c2 r; r.x = a.x * b.x - a.y * b.y + c.x; r.y = a.x * b.y + a.y * b.x + c.y; return r; }
__device__ __forceinline__ void k_s5_scanmm(int wv, const float* a_re, const float* a_im, const float* log_dt, const bf16_t* __restrict__ Pt, bf16_t* __restrict__ UH) {
  const int lane = lane_opq(), fr = lane & 15, fq = lane >> 4, tid_ = wv * 64 + lane;
  const int dir = wv >> 2, wq = wv & 3, p = wq * 16 + fr;
  bf16_t* AB = (bf16_t*)dyn_lds();
  constexpr int TS = 16 * 264;
  for (int item = blockIdx.x; item < 2 * G; item += gridDim.x) {
    const int gsel = ((item >> 5) << 3) | (item & 7), g = (gsel & 31) * 4 + ((item >> 3) & 3), b = gsel >> 5;
    const int gp = (dir * G + g) * P + p; const float dt = expf(log_dt[dir * G + g]);
    c2 L1; { const float mag = expf(16.0f * a_re[gp] * dt); float sn, cs; sincosf(16.0f * a_im[gp] * dt, &sn, &cs); L1 = {mag * cs, mag * sn}; }
    const c2 L2 = cmul(L1, L1), L4 = cmul(L2, L2);
    bf16x8 bre[8], bim[8];
    const bf16_t* Pg = Pt + (size_t)g * 256 * 256;
#pragma unroll
    for (int ks = 0; ks < 8; ++ks) { bre[ks] = *(const bf16x8*)(Pg + (size_t)(dir * 128 + p) * 256 + ks * 32 + fq * 8); bim[ks] = *(const bf16x8*)(Pg + (size_t)(dir * 128 + 64 + p) * 256 + ks * 32 + fq * 8); }
    c2 Hin = {0.f, 0.f};
    bf16_t* Ug = UH + (size_t)g * S5_SLAB + (size_t)b * 272 * 512;
    const int srow = tid_ >> 5, scol = (tid_ & 31) * 8;
    auto tile_of = [&](int it, int d) { return d == 0 ? it : (it == 0 ? 0 : 17 - it); };
    pg8::u32x4 pre0, pre1;
    pre0 = *(const pg8::u32x4*)(Ug + (size_t)(tile_of(0, 0) * 16 + srow) * 512 + scol); pre1 = *(const pg8::u32x4*)(Ug + (size_t)(tile_of(0, 1) * 16 + srow) * 512 + scol);
    LDS_BARRIER();
    *(pg8::u32x4*)(AB + 0 * TS + srow * 264 + scol) = pre0; *(pg8::u32x4*)(AB + 1 * TS + srow * 264 + scol) = pre1;
    LDS_BARRIER();
    for (int it = 0; it < 17; ++it) {
      const int rt = tile_of(it, dir);
      if (it + 1 < 17) { pre0 = *(const pg8::u32x4*)(Ug + (size_t)(tile_of(it + 1, 0) * 16 + srow) * 512 + scol); pre1 = *(const pg8::u32x4*)(Ug + (size_t)(tile_of(it + 1, 1) * 16 + srow) * 512 + scol); }
      f32x4 are = {0.f, 0.f, 0.f, 0.f}, aim = {0.f, 0.f, 0.f, 0.f};
      const bf16_t* arow = AB + ((it & 1) * 2 + dir) * TS + fr * 264 + fq * 8;
#pragma unroll
      for (int ks = 0; ks < 8; ++ks) { const bf16x8 a = *(const bf16x8*)(arow + ks * 32);
        are = __builtin_amdgcn_mfma_f32_16x16x32_bf16(a, bre[ks], are, 0, 0, 0); aim = __builtin_amdgcn_mfma_f32_16x16x32_bf16(a, bim[ks], aim, 0, 0, 0); }
      c2 v[4];
#pragma unroll
      for (int k = 0; k < 4; ++k) { const int i = dir == 0 ? k : 3 - k; v[k] = {are[i], aim[i]}; }
      c2 e = v[0]; e = cfma(L1, e, v[1]); e = cfma(L1, e, v[2]); e = cfma(L1, e, v[3]);
      const int gq = dir == 0 ? fq : 3 - fq;
      c2 E[4];
#pragma unroll
      for (int k = 0; k < 4; ++k) { const int srcq = dir == 0 ? k : 3 - k; const int src = (srcq * 16 + fr) << 2;
        E[k].x = __int_as_float(__builtin_amdgcn_ds_bpermute(src, __float_as_int(e.x))); E[k].y = __int_as_float(__builtin_amdgcn_ds_bpermute(src, __float_as_int(e.y))); }
      const c2 C1 = cfma(L4, Hin, E[0]), C2 = cfma(L4, C1, E[1]), C3 = cfma(L4, C2, E[2]), Hout = cfma(L4, C3, E[3]);
      c2 hb = gq == 0 ? Hin : (gq == 1 ? C1 : (gq == 2 ? C2 : C3));
#pragma unroll
      for (int k = 0; k < 4; ++k) { const int i = dir == 0 ? k : 3 - k;
        bf16_t* dst = Ug + (size_t)(rt * 16 + fq * 4 + i) * 512 + 256 + dir * 128 + p;
        dst[0] = f2bf(hb.x); dst[64] = f2bf(hb.y);
        hb = cfma(L1, hb, v[k]); }
      Hin = Hout;
      if (it + 1 < 17) { *(pg8::u32x4*)(AB + (((it + 1) & 1) * 2 + 0) * TS + srow * 264 + scol) = pre0; *(pg8::u32x4*)(AB + (((it + 1) & 1) * 2 + 1) * TS + srow * 264 + scol) = pre1; }
      LDS_BARRIER();
    }
  }
}
__device__ __forceinline__ float fgelu_tanh(float x) { const float u = 0.7978845608028654f * (x + 0.044715f * x * x * x); const float t = 1.0f - 2.0f * __builtin_amdgcn_rcpf(1.0f + __expf(2.0f * u)); return 0.5f * x * (1.0f + t); }
__device__ __forceinline__ void k_s5_outmm(int wv, const bf16_t* __restrict__ TQt, const bf16_t* __restrict__ UH, bf16_t* __restrict__ Zb, int col_major) {
  const int lane = lane_opq(), fr = lane & 15, fq = lane >> 4, tid_ = wv * 64 + lane;
  bf16_t* AB = (bf16_t*)dyn_lds();
  constexpr int TS = 16 * 520;
  for (int item = blockIdx.x; item < 2 * G; item += gridDim.x) {
    const int gsel = ((item >> 5) << 3) | (item & 7), g = (gsel & 31) * 4 + ((item >> 3) & 3), b = gsel >> 5;
    const bf16_t* Tg = TQt + (size_t)g * 256 * 512;
    bf16x8 bfr[2][16];
#pragma unroll
    for (int ct = 0; ct < 2; ++ct)
#pragma unroll
      for (int ks = 0; ks < 16; ++ks) bfr[ct][ks] = *(const bf16x8*)(Tg + (size_t)(wv * 32 + ct * 16 + fr) * 512 + ks * 32 + fq * 8);
    const bf16_t* Ug = UH + (size_t)g * S5_SLAB + (size_t)b * 272 * 512;
    const int srow = tid_ >> 6, scol = (tid_ & 63) * 8;
    pg8::u32x4 pre0, pre1;
    pre0 = *(const pg8::u32x4*)(Ug + (size_t)srow * 512 + scol); pre1 = *(const pg8::u32x4*)(Ug + (size_t)(srow + 8) * 512 + scol);
    LDS_BARRIER();
    *(pg8::u32x4*)(AB + srow * 520 + scol) = pre0; *(pg8::u32x4*)(AB + (srow + 8) * 520 + scol) = pre1;
    LDS_BARRIER();
    for (int rt = 0; rt < 17; ++rt) {
      if (rt + 1 < 17) { pre0 = *(const pg8::u32x4*)(Ug + (size_t)((rt + 1) * 16 + srow) * 512 + scol); pre1 = *(const pg8::u32x4*)(Ug + (size_t)((rt + 1) * 16 + srow + 8) * 512 + scol); }
      f32x4 acc0 = {0.f, 0.f, 0.f, 0.f}, acc1 = {0.f, 0.f, 0.f, 0.f};
      const bf16_t* arow = AB + (rt & 1) * TS + fr * 520 + fq * 8;
#pragma unroll
      for (int ks = 0; ks < 16; ++ks) { const bf16x8 a = *(const bf16x8*)(arow + ks * 32);
        acc0 = __builtin_amdgcn_mfma_f32_16x16x32_bf16(a, bfr[0][ks], acc0, 0, 0, 0); acc1 = __builtin_amdgcn_mfma_f32_16x16x32_bf16(a, bfr[1][ks], acc1, 0, 0, 0); }
#pragma unroll
      for (int i = 0; i < 4; ++i) { const int c = rt * 16 + fq * 4 + i;
#pragma unroll
        for (int ct = 0; ct < 2; ++ct) { const int t = wv * 2 + ct; const int row = s5_token_row(b, c * 16 + t, col_major);
          Zb[(size_t)row * D + g * 16 + fr] = f2bf(fgelu_tanh(ct ? acc1[i] : acc0[i])); } }
      if (rt + 1 < 17) { *(pg8::u32x4*)(AB + ((rt + 1) & 1) * TS + srow * 520 + scol) = pre0; *(pg8::u32x4*)(AB + ((rt + 1) & 1) * TS + (srow + 8) * 520 + scol) = pre1; }
      LDS_BARRIER();
    }
  }
}

constexpr int GDN_NCH = 68, GDN_ITEMS = NBATCH * GDN_NCH * 32 * 2;
__device__ __forceinline__ int gdn_row(int b, int ch, int ri) { return ch < 4 ? ML + b * CTXL + ch * 64 + ri : b * SEQ + (ch - 4) * 64 + ri; }
__device__ __forceinline__ int gdn_seq_lo(int row) { return row < ML ? (row & ~(SEQ - 1)) : ML + ((row - ML) & ~(CTXL - 1)); }
__device__ __forceinline__ int gdn_seq_hi(int row) { return row < ML ? (row | (SEQ - 1)) : ML + ((row - ML) | (CTXL - 1)); }
__device__ __forceinline__ void k_gdn_feat(int wv, const bf16_t* __restrict__ proj, const float* __restrict__ gab, const float* __restrict__ cw, const float* __restrict__ a_log, const float* __restrict__ dt_bias,
                                           bf16_t* __restrict__ qn, bf16_t* __restrict__ kn, bf16_t* __restrict__ vv, float* __restrict__ gg, float* __restrict__ bt) {
  const int lane = lane_opq(), tid_ = wv * 64 + lane;
  float* cws = (float*)dyn_lds();
  __syncthreads();
  for (int e = tid_; e < 4 * GDN_CONV / 4; e += 512) ((f32x4*)cws)[e] = ((const f32x4*)cw)[e];
  __syncthreads();
  constexpr int RPB = MT / 256;
  const int chA = tid_ * 8, chB = 4096 + tid_ * 8;
  f32x4 c4[4];
#pragma unroll
  for (int q = 0; q < 4; ++q) c4[q] = *(const f32x4*)(cw + 4 * GDN_CONV + (q < 2 ? chA : chB) + 4 * (q & 1));
  for (int rb = blockIdx.x * RPB; rb < MT; rb += gridDim.x * RPB) {
    for (int r0 = rb; r0 < rb + RPB; r0 += 2) {
      f32x4 x[6][4];
      pg8::u32x4 xr[6][2];
#pragma unroll
      for (int k = 0; k < 6; ++k) { int rr = r0 + k - 2; rr = rr < 0 ? 0 : (rr > MT - 1 ? MT - 1 : rr);
        xr[k][0] = *(const pg8::u32x4*)(proj + (size_t)rr * 12288 + chA); xr[k][1] = *(const pg8::u32x4*)(proj + (size_t)rr * 12288 + chB); }
#pragma unroll
      for (int k = 0; k < 6; ++k)
#pragma unroll
        for (int q = 0; q < 4; ++q) { const unsigned lo = xr[k][q >> 1][(q & 1) * 2], hi = xr[k][q >> 1][(q & 1) * 2 + 1];
          x[k][q] = (f32x4){__uint_as_float(lo << 16), __uint_as_float(lo & 0xFFFF0000u), __uint_as_float(hi << 16), __uint_as_float(hi & 0xFFFF0000u)}; }
#pragma unroll
      for (int ro = 0; ro < 2; ++ro) { const int row = r0 + ro; const int lo = gdn_seq_lo(row), hi = gdn_seq_hi(row);
        f32x4 a[4] = {{0.f, 0.f, 0.f, 0.f}, {0.f, 0.f, 0.f, 0.f}, {0.f, 0.f, 0.f, 0.f}, {0.f, 0.f, 0.f, 0.f}};
#pragma unroll
        for (int k = 0; k < 5; ++k) { const int rr = row + k - 2; const float ok = (rr >= lo && rr <= hi) ? 1.0f : 0.0f;
#pragma unroll
          for (int q = 0; q < 4; ++q) { const f32x4 w = (k < 4) ? *(const f32x4*)(cws + k * GDN_CONV + (q < 2 ? chA : chB) + 4 * (q & 1)) : c4[q]; a[q] += x[ro + k][q] * (w * ok); } }
        float ss = 0.f;
#pragma unroll
        for (int q = 0; q < 4; ++q)
#pragma unroll
          for (int jj = 0; jj < 4; ++jj) { const float v = fsilu(a[q][jj]); a[q][jj] = v; if (q < 2) ss += v * v; }
        ss += __int_as_float(__builtin_amdgcn_ds_bpermute((lane ^ 1) << 2, __float_as_int(ss)));
        ss += __int_as_float(__builtin_amdgcn_ds_bpermute((lane ^ 2) << 2, __float_as_int(ss)));
        ss += __int_as_float(__builtin_amdgcn_ds_bpermute((lane ^ 4) << 2, __float_as_int(ss)));
        ss += __int_as_float(__builtin_amdgcn_ds_bpermute((lane ^ 8) << 2, __float_as_int(ss)));
        const float sc = rsqrtf(ss + 1e-6f);
        bf16_t* dA = chA < 2048 ? qn + (size_t)row * 2048 + chA : kn + (size_t)row * 2048 + chA - 2048;
        *(pg8::u32x4*)dA = (pg8::u32x4){pg8::cvt_pk_bf16(a[0][0] * sc, a[0][1] * sc), pg8::cvt_pk_bf16(a[0][2] * sc, a[0][3] * sc), pg8::cvt_pk_bf16(a[1][0] * sc, a[1][1] * sc), pg8::cvt_pk_bf16(a[1][2] * sc, a[1][3] * sc)};
        *(pg8::u32x4*)(vv + (size_t)row * 4096 + tid_ * 8) = (pg8::u32x4){pg8::cvt_pk_bf16(a[2][0], a[2][1]), pg8::cvt_pk_bf16(a[2][2], a[2][3]), pg8::cvt_pk_bf16(a[3][0], a[3][1]), pg8::cvt_pk_bf16(a[3][2], a[3][3])};
      }
    }
  }
  for (int i = blockIdx.x * 512 + tid_; i < MT * 64; i += gridDim.x * 512) {
    const int row = i >> 6, j = i & 63;
    const float a = gab[(size_t)row * 256 + j], b = gab[(size_t)row * 256 + 64 + j];
    const float xx = a + dt_bias[j];
    const float sp = xx > 20.f ? xx : log1pf(expf(xx));
    gg[i] = -expf(a_log[j]) * sp;
    bt[i] = sigmoid_f(b);
  }
}
constexpr int GA_KN = 0, GA_QN = 17408, GA_KK = 34816, GA_QK = 51456, GA_L = 68096;
__device__ __forceinline__ void k_gdn_prep(int wv, const bf16_t* __restrict__ qn, const bf16_t* __restrict__ kn, const float* __restrict__ gg, const float* __restrict__ bt,
                                           bf16_t* __restrict__ tinv, bf16_t* __restrict__ attn, float* __restrict__ gcbuf) {
  const int lane = lane_opq(), fr = lane & 15, fq = lane >> 4, tid_ = wv * 64 + lane;
  unsigned char* lds = dyn_lds();
  bf16_t* Kn = (bf16_t*)(lds + GA_KN); bf16_t* Qn = (bf16_t*)(lds + GA_QN); float* KK = (float*)(lds + GA_KK); float* QK = (float*)(lds + GA_QK);
  pg8::u32x4 pk[2], pq[2];
  auto fetch = [&](int sit2) { const int hk = sit2 & 15, ch = (sit2 >> 4) % GDN_NCH, b = sit2 / (16 * GDN_NCH);
#pragma unroll
    for (int it = 0; it < 2; ++it) { const int pc = tid_ + it * 512, i = pc >> 4, dp = (pc & 15) * 8; const size_t src = (size_t)gdn_row(b, ch, i) * 2048 + hk * 128 + dp;
      pk[it] = *(const pg8::u32x4*)(kn + src); pq[it] = *(const pg8::u32x4*)(qn + src); } };
  if ((int)blockIdx.x < NBATCH * GDN_NCH * 16) fetch(blockIdx.x);
  for (int sit = blockIdx.x; sit < NBATCH * GDN_NCH * 16; sit += gridDim.x) {
    const int hk = sit & 15, ch = (sit >> 4) % GDN_NCH, b = sit / (16 * GDN_NCH);
    LDS_BARRIER();
#pragma unroll
    for (int it = 0; it < 2; ++it) { const int pc = tid_ + it * 512, i = pc >> 4, dp = (pc & 15) * 8;
      *(pg8::u32x4*)(Kn + i * 136 + dp) = pk[it]; *(pg8::u32x4*)(Qn + i * 136 + dp) = pq[it]; }
    LDS_BARRIER();
    if (sit + (int)gridDim.x < NBATCH * GDN_NCH * 16) fetch(sit + gridDim.x);
#pragma unroll
    for (int tl = 0; tl < 4; ++tl) { const int tt = wv * 4 + tl, mat = tt >> 4, ti = (tt >> 2) & 3, tj = tt & 3;
      const bf16_t* A = (mat ? Qn : Kn) + (ti * 16 + fr) * 136 + fq * 8; const bf16_t* B = Kn + (tj * 16 + fr) * 136 + fq * 8;
      f32x4 acc = {0.f, 0.f, 0.f, 0.f};
#pragma unroll
      for (int ks = 0; ks < 4; ++ks) acc = __builtin_amdgcn_mfma_f32_16x16x32_bf16(*(const bf16x8*)(A + ks * 32), *(const bf16x8*)(B + ks * 32), acc, 0, 0, 0);
      float* O = mat ? QK : KK;
#pragma unroll
      for (int r = 0; r < 4; ++r) O[(ti * 16 + fq * 4 + r) * 65 + tj * 16 + fr] = acc[r]; }
    LDS_BARRIER();
    {
      const int wq = wv & 3, role = wv >> 2;
      const int dir = wq & 1, hv = hk * 2 + (wq >> 1);
      const int item = ((b * GDN_NCH + ch) * 32 + hv) * 2 + dir;
      float* Lw = (float*)(lds + GA_L) + wq * 4096;
      const int rl = dir ? 63 - lane : lane; const int rowl = gdn_row(b, ch, rl);
      float gcv = gg[(size_t)rowl * 64 + dir * 32 + hv]; const float bel = bt[(size_t)rowl * 64 + dir * 32 + hv];
#pragma unroll
      for (int o = 1; o < 64; o <<= 1) { const float up = __int_as_float(__builtin_amdgcn_ds_bpermute(((lane - o) & 63) << 2, __float_as_int(gcv))); if (lane >= o) gcv += up; }
      if (role == 1) {
        gcbuf[(size_t)item * 64 + lane] = gcv;
        for (int i = 0; i < 64; ++i) {
          const float gci = __int_as_float(__builtin_amdgcn_readlane(__float_as_int(gcv), i));
          const int ri = dir ? 63 - i : i;
          const float dec = __expf(i >= lane ? gci - gcv : 0.f);
          attn[(size_t)item * 4096 + i * 64 + lane] = f2bf(i >= lane ? QK[ri * 65 + rl] * 0.08838834764831845f * dec : 0.f);
        }
      } else {
        for (int i = 0; i < 64; ++i) {
          const float gci = __int_as_float(__builtin_amdgcn_readlane(__float_as_int(gcv), i)), bei = __int_as_float(__builtin_amdgcn_readlane(__float_as_int(bel), i));
          const int ri = dir ? 63 - i : i;
          const float dec = __expf(i >= lane ? gci - gcv : 0.f);
          Lw[i * 64 + lane] = i > lane ? bei * KK[ri * 65 + rl] * dec : 0.f;
        }
        asm volatile("s_waitcnt lgkmcnt(0)" ::: "memory");
        float x[64];
#pragma unroll
        for (int i = 0; i < 64; ++i) {
          float a = (i == lane) ? 1.0f : 0.0f;
#pragma unroll
          for (int j4 = 0; j4 < (i + 3) / 4; ++j4) { const f32x4 l4 = *(const f32x4*)(Lw + i * 64 + j4 * 4);
#pragma unroll
            for (int u = 0; u < 4; ++u) if (j4 * 4 + u < i) a -= l4[u] * x[j4 * 4 + u]; }
          x[i] = a;
          tinv[(size_t)item * 4096 + i * 64 + lane] = f2bf(a);
        }
      }
    }
  }
}
constexpr int GB_KBG = 0, GB_QG = 17408, GB_KGT = 34816, GB_TI = 53248, GB_AT = 62464, GB_VB = 71680, GB_RT = 89088, GB_VNT = 98304, GB_STB = 107520;
__device__ __forceinline__ void k_gdn_chain(int wv, const bf16_t* __restrict__ qn, const bf16_t* __restrict__ kn, const bf16_t* __restrict__ vv, const float* __restrict__ bt,
                                            const bf16_t* __restrict__ tinv, const bf16_t* __restrict__ attn, const float* __restrict__ gcbuf, bf16_t* __restrict__ odir) {
  const int lane = lane_opq(), fr = lane & 15, fq = lane >> 4, tid_ = wv * 64 + lane;
  unsigned char* lds = dyn_lds();
  bf16_t* KR = (bf16_t*)(lds + GB_KBG); bf16_t* QR = (bf16_t*)(lds + GB_QG); bf16_t* VNS = (bf16_t*)(lds + GB_KGT); bf16_t* VR = (bf16_t*)(lds + GB_KGT + 9216); bf16_t* TI = (bf16_t*)(lds + GB_TI); bf16_t* AT = (bf16_t*)(lds + GB_AT);
  float* EG = (float*)(lds + GB_VB); float* BE = EG + 64; float* EGL = EG + 128; bf16_t* RT = (bf16_t*)(lds + GB_RT); bf16_t* VNT = (bf16_t*)(lds + GB_VNT); bf16_t* STB = (bf16_t*)(lds + GB_STB);
  bf16x8 sel;
  { unsigned sw[4];
#pragma unroll
    for (int u = 0; u < 4; ++u) { const int k0 = fq * 8 + 2 * u, tgt = (wv & 1) * 16 + fr; sw[u] = (k0 == tgt ? 0x3F80u : 0u) | (k0 + 1 == tgt ? 0x3F800000u : 0u); }
    sel = __builtin_bit_cast(bf16x8, (pg8::u32x4){sw[0], sw[1], sw[2], sw[3]}); }
  for (int chain = blockIdx.x; chain < NBATCH * 32 * 2 * 2; chain += gridDim.x) {
    const int half = chain & 1, dir = (chain >> 1) & 1, hv = (chain >> 2) & 31, b = chain >> 7, hk = hv >> 1;
    LDS_BARRIER();
    for (int e = tid_; e < 64 * 136 / 2; e += 512) ((unsigned*)STB)[e] = 0u;
    f32x4 st[4];
#pragma unroll
    for (int et = 0; et < 4; ++et) st[et] = (f32x4){0.f, 0.f, 0.f, 0.f};
    struct Pre { pg8::u32x4 k[2], q[2], v, ti, at; float gci, be, gcl; };
    auto chunk_of = [&](int it) { return dir == 0 ? it : (it < 4 ? 3 - it : GDN_NCH + 3 - it); };
    auto fetch = [&](int it, Pre& P) {
      const int ch = chunk_of(it); const int item = ((b * GDN_NCH + ch) * 32 + hv) * 2 + dir;
      P.gcl = gcbuf[(size_t)item * 64 + 63];
      { const int row = gdn_row(b, ch, dir ? 63 - lane : lane); P.gci = gcbuf[(size_t)item * 64 + lane]; P.be = bt[(size_t)row * 64 + dir * 32 + hv]; }
#pragma unroll
      for (int it2 = 0; it2 < 2; ++it2) { const int pc = tid_ + it2 * 512, i = pc >> 4, dp = (pc & 15) * 8; const int row = gdn_row(b, ch, dir ? 63 - i : i);
        P.k[it2] = *(const pg8::u32x4*)(kn + (size_t)row * 2048 + hk * 128 + dp); P.q[it2] = *(const pg8::u32x4*)(qn + (size_t)row * 2048 + hk * 128 + dp); }
      { const int i = tid_ >> 3, ep = (tid_ & 7) * 8; const int row = gdn_row(b, ch, dir ? 63 - i : i);
        P.v = *(const pg8::u32x4*)(vv + (size_t)row * 4096 + hv * 128 + half * 64 + ep);
        P.ti = *(const pg8::u32x4*)(tinv + (size_t)item * 4096 + i * 64 + ep); P.at = *(const pg8::u32x4*)(attn + (size_t)item * 4096 + i * 64 + ep); }
    };
    Pre P; fetch(0, P);
    f32x4 osave[2];
    auto store_o = [&](int chp) {
#pragma unroll
      for (int tl = 0; tl < 2; ++tl) { const int t = wv * 2 + tl, ti = t >> 2, te = t & 3;
#pragma unroll
        for (int r = 0; r < 4; ++r) { const int i = ti * 16 + fq * 4 + r; const int row = gdn_row(b, chp, dir ? 63 - i : i);
          odir[((size_t)dir * MT + row) * GDN_V + hv * 128 + half * 64 + te * 16 + fr] = f2bf(osave[tl][r]); } }
    };
    for (int it = 0; it < GDN_NCH; ++it) {
      const float gcl = P.gcl;
#pragma unroll
      for (int it2 = 0; it2 < 2; ++it2) { const int pc = tid_ + it2 * 512, i = pc >> 4, dp = (pc & 15) * 8;
        *(pg8::u32x4*)(KR + i * 136 + dp) = P.k[it2]; *(pg8::u32x4*)(QR + i * 136 + dp) = P.q[it2]; }
      { const int i = tid_ >> 3, ep = (tid_ & 7) * 8;
        *(pg8::u32x4*)(VR + i * 72 + ep) = P.v; *(pg8::u32x4*)(TI + i * 72 + ep) = P.ti; *(pg8::u32x4*)(AT + i * 72 + ep) = P.at; }
      if (wv == 0) { EG[lane] = __expf(P.gci); BE[lane] = P.be; EGL[lane] = __expf(gcl - P.gci); }
      LDS_BARRIER();
      fetch(it + 1 < GDN_NCH ? it + 1 : it, P);
      if (it > 0) store_o(chunk_of(it - 1));
      const int ti = wv >> 1;
      const f32x4 eg4 = *(const f32x4*)(EG + ti * 16 + fq * 4), be4 = *(const f32x4*)(BE + ti * 16 + fq * 4);
      f32x4 o1[2];
#pragma unroll
      for (int tl = 0; tl < 2; ++tl) { const int te = (wv & 1) * 2 + tl;
        const bf16_t* Ak = KR + (ti * 16 + fr) * 136 + fq * 8; const bf16_t* Aq = QR + (ti * 16 + fr) * 136 + fq * 8; const bf16_t* B = STB + (te * 16 + fr) * 136 + fq * 8;
        f32x4 ks = {0.f, 0.f, 0.f, 0.f}; f32x4 oq = {0.f, 0.f, 0.f, 0.f};
#pragma unroll
        for (int kk = 0; kk < 4; ++kk) { const bf16x8 bb = *(const bf16x8*)(B + kk * 32);
          ks = __builtin_amdgcn_mfma_f32_16x16x32_bf16(*(const bf16x8*)(Ak + kk * 32), bb, ks, 0, 0, 0); oq = __builtin_amdgcn_mfma_f32_16x16x32_bf16(*(const bf16x8*)(Aq + kk * 32), bb, oq, 0, 0, 0); }
        float r4[4];
#pragma unroll
        for (int r = 0; r < 4; ++r) { const float vr = __uint_as_float((unsigned)VR[(ti * 16 + fq * 4 + r) * 72 + te * 16 + fr] << 16);
          r4[r] = be4[r] * (vr - eg4[r] * ks[r]); oq[r] *= eg4[r] * 0.08838834764831845f; }
        o1[tl] = oq;
        *(u32x2*)(RT + (te * 16 + fr) * 72 + ti * 16 + fq * 4) = (u32x2){pg8::cvt_pk_bf16(r4[0], r4[1]), pg8::cvt_pk_bf16(r4[2], r4[3])}; }
      bf16x8 kt[2];
      { unsigned kw[8];
#pragma unroll
        for (int t4 = 0; t4 < 4; ++t4) { const bf16x8 a = *(const bf16x8*)(KR + (t4 * 16 + fr) * 136 + (wv >> 1) * 32 + fq * 8);
          const f32x4 c = __builtin_amdgcn_mfma_f32_16x16x32_bf16(a, sel, (f32x4){0.f, 0.f, 0.f, 0.f}, 0, 0, 0);
          kw[t4 * 2] = pg8::cvt_pk_bf16(c[0], c[1]); kw[t4 * 2 + 1] = pg8::cvt_pk_bf16(c[2], c[3]); }
        kt[0] = __builtin_bit_cast(bf16x8, (pg8::u32x4){kw[0], kw[1], kw[2], kw[3]}); kt[1] = __builtin_bit_cast(bf16x8, (pg8::u32x4){kw[4], kw[5], kw[6], kw[7]}); }
      LDS_BARRIER();
      const f32x4 egl4 = *(const f32x4*)(EGL + ti * 16 + fq * 4);
#pragma unroll
      for (int tl = 0; tl < 2; ++tl) { const int te = (wv & 1) * 2 + tl;
        const bf16_t* A = TI + (ti * 16 + fr) * 72 + fq * 8; const bf16_t* B = RT + (te * 16 + fr) * 72 + fq * 8;
        f32x4 vn = {0.f, 0.f, 0.f, 0.f};
#pragma unroll
        for (int kk = 0; kk < 2; ++kk) vn = __builtin_amdgcn_mfma_f32_16x16x32_bf16(*(const bf16x8*)(A + kk * 32), *(const bf16x8*)(B + kk * 32), vn, 0, 0, 0);
        *(u32x2*)(VNT + (te * 16 + fr) * 72 + ti * 16 + fq * 4) = (u32x2){pg8::cvt_pk_bf16(vn[0], vn[1]), pg8::cvt_pk_bf16(vn[2], vn[3])};
        *(u32x2*)(VNS + (te * 16 + fr) * 72 + ti * 16 + fq * 4) = (u32x2){pg8::cvt_pk_bf16(vn[0] * egl4[0], vn[1] * egl4[1]), pg8::cvt_pk_bf16(vn[2] * egl4[2], vn[3] * egl4[3])}; }
      LDS_BARRIER();
#pragma unroll
      for (int tl = 0; tl < 2; ++tl) { const int te = (wv & 1) * 2 + tl;
        const bf16_t* A = AT + (ti * 16 + fr) * 72 + fq * 8; const bf16_t* B = VNT + (te * 16 + fr) * 72 + fq * 8;
        f32x4 o = o1[tl];
#pragma unroll
        for (int kk = 0; kk < 2; ++kk) o = __builtin_amdgcn_mfma_f32_16x16x32_bf16(*(const bf16x8*)(A + kk * 32), *(const bf16x8*)(B + kk * 32), o, 0, 0, 0);
        osave[tl] = o; }
      const float gl = __expf(gcl);
#pragma unroll
      for (int et = 0; et < 4; ++et) { const bf16_t* Bv = VNS + (et * 16 + fr) * 72 + fq * 4;
        f32x4 a = st[et] * gl;
#pragma unroll
        for (int kk = 0; kk < 2; ++kk) { const u32x2 lo = *(const u32x2*)(Bv + kk * 32), hi = *(const u32x2*)(Bv + kk * 32 + 16);
          a = __builtin_amdgcn_mfma_f32_16x16x32_bf16(kt[kk], __builtin_bit_cast(bf16x8, (pg8::u32x4){lo[0], lo[1], hi[0], hi[1]}), a, 0, 0, 0); }
        st[et] = a;
        *(u32x2*)(STB + (et * 16 + fr) * 136 + wv * 16 + fq * 4) = (u32x2){pg8::cvt_pk_bf16(a[0], a[1]), pg8::cvt_pk_bf16(a[2], a[3])}; }
      LDS_BARRIER();
    }
    store_o(chunk_of(GDN_NCH - 1));
  }
}
__device__ __forceinline__ void k_gdn_gate2(int wv, const bf16_t* __restrict__ odir, const bf16_t* __restrict__ proj, const float* __restrict__ norm_g, bf16_t* __restrict__ og) {
  const int lane = lane_opq(), tid_ = wv * 64 + lane;
  constexpr int RPB = MT / 256;
  const int ch0 = tid_ * 8;
  float ng[8];
#pragma unroll
  for (int q = 0; q < 8; ++q) ng[q] = norm_g[(ch0 & 127) + q];
  for (int rb = blockIdx.x * RPB; rb < MT; rb += gridDim.x * RPB) {
    for (int r0 = rb; r0 < rb + RPB; r0 += 2) {
      pg8::u32x4 oa[2], ob[2], zz[2];
#pragma unroll
      for (int ro = 0; ro < 2; ++ro) { const size_t row = r0 + ro;
        oa[ro] = *(const pg8::u32x4*)(odir + row * GDN_V + ch0); ob[ro] = *(const pg8::u32x4*)(odir + ((size_t)MT + row) * GDN_V + ch0);
        zz[ro] = *(const pg8::u32x4*)(proj + row * 12288 + GDN_CONV + ch0); }
#pragma unroll
      for (int ro = 0; ro < 2; ++ro) { const size_t row = r0 + ro;
        float o[8], z[8]; float ss = 0.f;
#pragma unroll
        for (int q = 0; q < 4; ++q) { o[2 * q] = __uint_as_float(oa[ro][q] << 16) + __uint_as_float(ob[ro][q] << 16); o[2 * q + 1] = __uint_as_float(oa[ro][q] & 0xFFFF0000u) + __uint_as_float(ob[ro][q] & 0xFFFF0000u);
          z[2 * q] = __uint_as_float(zz[ro][q] << 16); z[2 * q + 1] = __uint_as_float(zz[ro][q] & 0xFFFF0000u); ss += o[2 * q] * o[2 * q] + o[2 * q + 1] * o[2 * q + 1]; }
        ss += __int_as_float(__builtin_amdgcn_ds_bpermute((lane ^ 1) << 2, __float_as_int(ss)));
        ss += __int_as_float(__builtin_amdgcn_ds_bpermute((lane ^ 2) << 2, __float_as_int(ss)));
        ss += __int_as_float(__builtin_amdgcn_ds_bpermute((lane ^ 4) << 2, __float_as_int(ss)));
        ss += __int_as_float(__builtin_amdgcn_ds_bpermute((lane ^ 8) << 2, __float_as_int(ss)));
        const float r = rsqrtf(ss * (1.0f / 128.0f) + 1e-6f);
        unsigned w4[4];
#pragma unroll
        for (int q = 0; q < 4; ++q) w4[q] = pg8::cvt_pk_bf16(o[2 * q] * r * ng[2 * q] * fsilu(z[2 * q]), o[2 * q + 1] * r * ng[2 * q + 1] * fsilu(z[2 * q + 1]));
        *(pg8::u32x4*)(og + row * GDN_V + ch0) = (pg8::u32x4){w4[0], w4[1], w4[2], w4[3]};
      }
    }
  }
}

__device__ __forceinline__ void k_gdn_conv(int wv, const float* proj, const float* cw, float* qkv) {
  const size_t n = (size_t)MT * GDN_CONV;
  for (size_t i = (size_t)blockIdx.x * blockDim.x + otid(wv); i < n; i += (size_t)gridDim.x * blockDim.x) {
    const int row = (int)(i / GDN_CONV), col = (int)(i % GDN_CONV);
    int t, len;
    if (row < ML) { t = row % SEQ; len = SEQ; } else { t = (row - ML) % CTXL; len = CTXL; }
    float a = 0.f;
#pragma unroll
    for (int k = 0; k < 5; ++k) { const int tt = t + k - 2; if (tt >= 0 && tt < len) a += proj[(size_t)(row + k - 2) * GDN_LD + col] * cw[k * GDN_CONV + col]; }
    qkv[i] = silu_f(a);
  }
}
__device__ __forceinline__ void k_gdn_l2(int wv, float* qkv) {
  const int lane = otid(wv) & 63;
  const size_t wave = ((size_t)blockIdx.x * blockDim.x + otid(wv)) >> 6, nw = ((size_t)gridDim.x * blockDim.x) >> 6;
  for (size_t item = wave; item < (size_t)MT * 32; item += nw) {
    float* p = qkv + (item / 32) * GDN_CONV + (item % 32) * 128;
    const float a = p[lane], b = p[lane + 64];
    const float ss = wave_sum(a * a + b * b);
    const float r = rsqrtf(ss + 1e-6f);
    p[lane] = a * r; p[lane + 64] = b * r;
  }
}
__device__ __forceinline__ void k_gdn_gates(int wv, const float* proj, const float* a_log, const float* dt_bias, float* gg, float* bt) {
  const size_t n = (size_t)MT * 64;
  for (size_t i = (size_t)blockIdx.x * blockDim.x + otid(wv); i < n; i += (size_t)gridDim.x * blockDim.x) {
    const int row = (int)(i / 64), j = (int)(i % 64);
    const float a = proj[(size_t)row * GDN_LD + GDN_CONV + GDN_V + j], b = proj[(size_t)row * GDN_LD + GDN_CONV + GDN_V + 64 + j];
    const float xx = a + dt_bias[j];
    const float sp = xx > 20.f ? xx : log1pf(expf(xx));
    gg[i] = -expf(a_log[j]) * sp;
    bt[i] = sigmoid_f(b);
  }
}
__device__ __forceinline__ void k_gdn_rec(int wv, const float* __restrict__ qkv, const float* __restrict__ gg, const float* __restrict__ bt, float* odir) {
  int tid_ = otid(wv);
  float* red = (float*)dyn_lds();
  const int e = tid_ & 127, qd = tid_ >> 7;
  __syncthreads();
  for (int item = blockIdx.x; item < NBATCH * 32 * 2; item += gridDim.x) {
    const int dir = item & 1, hv = (item >> 1) & 31, b = item >> 6, hk = hv >> 1;
    float S[32];
#pragma unroll
    for (int d = 0; d < 32; ++d) S[d] = 0.f;
    for (int s = 0; s < CTXL + SEQ; ++s) {
      int row;
      if (s < CTXL) { const int t = dir ? CTXL - 1 - s : s; row = ML + b * CTXL + t; }
      else { int q = s - CTXL; if (dir) q = SEQ - 1 - q; row = b * SEQ + q; }
      const float* qp = qkv + (size_t)row * GDN_CONV + hk * 128 + qd * 32;
      const float* kp = qkv + (size_t)row * GDN_CONV + 2048 + hk * 128 + qd * 32;
      const float v = qkv[(size_t)row * GDN_CONV + 4096 + hv * 128 + e];
      const float a = expf(gg[(size_t)row * 64 + dir * 32 + hv]), beta = bt[(size_t)row * 64 + dir * 32 + hv];
      float dot = 0.f;
#pragma unroll
      for (int d = 0; d < 32; ++d) { S[d] *= a; dot += S[d] * kp[d]; }
      red[qd * 128 + e] = dot;
      __syncthreads();
      dot = (red[e] + red[128 + e]) + (red[256 + e] + red[384 + e]);
      const float vn = beta * (v - dot);
      float o = 0.f;
#pragma unroll
      for (int d = 0; d < 32; ++d) { S[d] += kp[d] * vn; o += S[d] * qp[d]; }
      red[(4 + qd) * 128 + e] = o;
      __syncthreads();
      if (qd == 0) odir[((size_t)dir * MT + row) * GDN_V + hv * 128 + e] = ((red[512 + e] + red[640 + e]) + (red[768 + e] + red[896 + e])) * 0.08838834764831845f;
    }
  }
}
__device__ __forceinline__ void k_gdn_gate(int wv, const float* odir, const float* proj, const float* norm_g, float* og) {
  int tid_ = otid(wv);
  const int lane = tid_ & 63;
  const size_t wave = ((size_t)blockIdx.x * blockDim.x + tid_) >> 6, nw = ((size_t)gridDim.x * blockDim.x) >> 6;
  for (size_t item = wave; item < (size_t)MT * 32; item += nw) {
    const size_t row = item / 32; const int hv = (int)(item % 32);
    const size_t o0 = row * GDN_V + hv * 128, o1 = ((size_t)MT + row) * GDN_V + hv * 128;
    const float a = odir[o0 + lane] + odir[o1 + lane], b = odir[o0 + lane + 64] + odir[o1 + lane + 64];
    const float ms = wave_sum(a * a + b * b) * (1.0f / 128.0f);
    const float r = rsqrtf(ms + 1e-6f);
    const float za = proj[row * GDN_LD + GDN_CONV + hv * 128 + lane], zb = proj[row * GDN_LD + GDN_CONV + hv * 128 + lane + 64];
    og[o0 + lane] = a * r * norm_g[lane] * silu_f(za);
    og[o0 + lane + 64] = b * r * norm_g[lane + 64] * silu_f(zb);
  }
}

__device__ __forceinline__ int stream_of_pm(int pm) { return pm < 16 ? 0 : (pm < 32 ? 1 : 2); }

__device__ __forceinline__ void k_cvt_t(int wv, const float* __restrict__ W, int ldw, int K, int ncols, bf16_t* __restrict__ dst, int mode, int off, int first = 0, int nb = 0) {
  int tid_ = otid(wv);
  float* T = (float*)dyn_lds();
  const int col4 = tid_ & 127, kr = tid_ >> 7, lane = tid_ & 63, kp = lane & 31, csel = lane >> 5;
  const int tk = K / 64, tc = (ncols + 511) / 512;
  if (nb == 0) nb = gridDim.x;
  if ((int)blockIdx.x < first || (int)blockIdx.x >= first + nb) return;
  const int ntile = tk * tc;
  int t = blockIdx.x - first;
  if (t >= ntile) return;
  f32x4 v[16];
  auto issue = [&](int tt) { const int k0 = (tt / tc) * 64, c0 = (tt % tc) * 512; const int c = c0 + 4 * col4; const int cl = c < ncols ? c : 0;
#pragma unroll
    for (int q = 0; q < 16; ++q) v[q] = *(const f32x4*)(W + (size_t)(k0 + kr + 4 * q) * ldw + cl); };
  issue(t);
  for (; t < ntile; t += nb) {
    const int k0 = (t / tc) * 64, c0 = (t % tc) * 512;
    __syncthreads();
#pragma unroll
    for (int q = 0; q < 16; ++q) *(f32x4*)(T + (kr + 4 * q) * 516 + 4 * col4) = v[q];
    __syncthreads();
    if (t + nb < ntile) issue(t + nb);
#pragma unroll 8
    for (int q = 0; q < 32; ++q) { const int cc = wv * 64 + 2 * q + csel, gc = c0 + cc;
      if (gc < ncols) { const float a = T[(2 * kp) * 516 + cc], b = T[(2 * kp + 1) * 516 + cc];
        const int r = mode ? ((gc >> 4) * 32 + (gc & 15) + off) : gc;
        *(unsigned*)(dst + (size_t)r * K + k0 + 2 * kp) = pg8::cvt_pk_bf16(a, b); } }
  }
}
__device__ __forceinline__ void k_zero_bf16(int wv, bf16_t* p, size_t n) { for (size_t i = (size_t)blockIdx.x * blockDim.x + otid(wv); i < n; i += (size_t)gridDim.x * blockDim.x) p[i] = 0; }
__device__ __forceinline__ void k_f2bf(int wv, const float* a, bf16_t* o, size_t n) { for (size_t i = (size_t)blockIdx.x * blockDim.x + otid(wv); i < n; i += (size_t)gridDim.x * blockDim.x) o[i] = f2bf(a[i]); }

struct EpiStoreF32 {
  static constexpr bool PERM = false, AFTER_DRAIN = false;
  float* C; const float* bias; int ldc, pad_;
  __device__ __forceinline__ void operator()(const f32x4 (&acc)[2][2][4][2], const Unit& u, int wr, int wc, int fr, int fq) const {
    const int row0 = u.pm * 256 + wr * 64 + fr, col0 = u.pn * 256 + wc * 32 + 4 * fq;
#pragma unroll
    for (int ai = 0; ai < 2; ++ai)
#pragma unroll
      for (int m = 0; m < 4; ++m) { float* rowp = C + (size_t)(row0 + ai * 128 + m * 16) * ldc + col0;
#pragma unroll
        for (int bj = 0; bj < 2; ++bj)
#pragma unroll
          for (int n = 0; n < 2; ++n) { f32x4 v = acc[ai][bj][m][n]; if (bias) v += *(const f32x4*)(bias + col0 + bj * 128 + n * 16); *(f32x4*)(rowp + bj * 128 + n * 16) = v; } }
  }
};
struct EpiStoreRowBias {
  static constexpr bool PERM = false, AFTER_DRAIN = false;
  float* C; const float* bias; int ldc, pad_;
  __device__ __forceinline__ void operator()(const f32x4 (&acc)[2][2][4][2], const Unit& u, int wr, int wc, int fr, int fq) const {
    const int row0 = u.pm * 256 + wr * 64 + fr, col0 = u.pn * 256 + wc * 32 + 4 * fq;
#pragma unroll
    for (int ai = 0; ai < 2; ++ai)
#pragma unroll
      for (int m = 0; m < 4; ++m) { const int row = row0 + ai * 128 + m * 16; float* rowp = C + (size_t)row * ldc + col0; const float b = bias[row];
#pragma unroll
        for (int bj = 0; bj < 2; ++bj)
#pragma unroll
          for (int n = 0; n < 2; ++n) { f32x4 v = acc[ai][bj][m][n]; v += b; *(f32x4*)(rowp + bj * 128 + n * 16) = v; } }
  }
};
struct EpiFilt {
  static constexpr bool PERM = false, AFTER_DRAIN = false;
  float* C; int ldc, pad_;
  __device__ __forceinline__ void operator()(const f32x4 (&acc)[2][2][4][2], const Unit& u, int wr, int wc, int fr, int fq) const {
    const int row0 = u.pm * 256 + wr * 64 + fr, col0 = u.pn * 256 + wc * 32 + 4 * fq;
    const float mind = -3.0701134573253945f, maxd = -15.350567286626973f;
#pragma unroll
    for (int ai = 0; ai < 2; ++ai)
#pragma unroll
      for (int m = 0; m < 4; ++m) { const int row = row0 + ai * 128 + m * 16; float* rowp = C + (size_t)row * ldc + col0;
        const float delta = fabsf(mind + (maxd - mind) * (float)(row & (D - 1)) / (float)(D - 1));
#pragma unroll
        for (int bj = 0; bj < 2; ++bj)
#pragma unroll
          for (int n = 0; n < 2; ++n) { f32x4 v = acc[ai][bj][m][n];
#pragma unroll
            for (int jj = 0; jj < 4; ++jj) { const int tt = col0 + bj * 128 + n * 16 + jj; const float tu = tt < SEQ ? (float)tt * (1.0f / (float)(SEQ - 1)) : (float)(tt - SEQ) * (1.0f / (float)(CTXL - 1)); v[jj] *= __expf(-tu * delta); }
            *(f32x4*)(rowp + bj * 128 + n * 16) = v; } }
  }
};
struct EpiProj {
  static constexpr bool PERM = false, AFTER_DRAIN = false;
  bf16_t* Pb; float* Gab;
  __device__ __forceinline__ void operator()(const f32x4 (&acc)[2][2][4][2], const Unit& u, int wr, int wc, int fr, int fq) const {
    const int row0 = u.pm * 256 + wr * 64 + fr, col0 = u.pn * 256 + wc * 32 + 4 * fq;
    if (u.pn == 48) {
#pragma unroll
      for (int ai = 0; ai < 2; ++ai)
#pragma unroll
        for (int m = 0; m < 4; ++m) { float* rowp = Gab + (size_t)(row0 + ai * 128 + m * 16) * 256 + (col0 - 12288);
#pragma unroll
          for (int bj = 0; bj < 2; ++bj)
#pragma unroll
            for (int n = 0; n < 2; ++n) *(f32x4*)(rowp + bj * 128 + n * 16) = acc[ai][bj][m][n]; }
    } else {
#pragma unroll
      for (int ai = 0; ai < 2; ++ai)
#pragma unroll
        for (int m = 0; m < 4; ++m) { bf16_t* rowp = Pb + (size_t)(row0 + ai * 128 + m * 16) * 12288 + col0;
#pragma unroll
          for (int bj = 0; bj < 2; ++bj)
#pragma unroll
            for (int n = 0; n < 2; ++n) { const f32x4 v = acc[ai][bj][m][n] + 0.0f;
              *(u32x2*)(rowp + bj * 128 + n * 16) = (u32x2){pg8::cvt_pk_bf16(v[0], v[1]), pg8::cvt_pk_bf16(v[2], v[3])}; } }
    }
  }
};
struct EpiSwiglu {
  static constexpr bool PERM = false, AFTER_DRAIN = false;
  bf16_t* O; int ldo, pad_;
  __device__ __forceinline__ void operator()(const f32x4 (&acc)[2][2][4][2], const Unit& u, int wr, int wc, int fr, int fq) const {
    const int row0 = u.pm * 256 + wr * 64 + fr;
#pragma unroll
    for (int ai = 0; ai < 2; ++ai)
#pragma unroll
      for (int m = 0; m < 4; ++m) { bf16_t* rowp = O + (size_t)(row0 + ai * 128 + m * 16) * ldo;
#pragma unroll
        for (int bj = 0; bj < 2; ++bj) { const int q = u.pn * 8 + bj * 4 + wc; const f32x4 g = acc[ai][bj][m][0], up = acc[ai][bj][m][1];
          u32x2 w; w.x = pg8::cvt_pk_bf16(fsilu(g[0]) * up[0], fsilu(g[1]) * up[1]); w.y = pg8::cvt_pk_bf16(fsilu(g[2]) * up[2], fsilu(g[3]) * up[3]);
          *(u32x2*)(rowp + q * 16 + 4 * fq) = w; } }
  }
};
struct EpiResid {
  static constexpr bool PERM = false, AFTER_DRAIN = false;
  float* X; const float* modl; const float* bias; int gi, pad_;
  __device__ __forceinline__ void operator()(const f32x4 (&acc)[2][2][4][2], const Unit& u, int wr, int wc, int fr, int fq) const {
    const int row0 = u.pm * 256 + wr * 64 + fr, col0 = u.pn * 256 + wc * 32 + 4 * fq;
    const float* gate = modl + (size_t)stream_of_pm(u.pm) * NMOD + gi * D;
#pragma unroll
    for (int bj = 0; bj < 2; ++bj)
#pragma unroll
      for (int n = 0; n < 2; ++n) { const int col = col0 + bj * 128 + n * 16; const f32x4 gv = *(const f32x4*)(gate + col);
        f32x4 bv = {0.f, 0.f, 0.f, 0.f}; if (bias) bv = *(const f32x4*)(bias + col);
#pragma unroll
        for (int ai = 0; ai < 2; ++ai)
#pragma unroll
          for (int m = 0; m < 4; ++m) { float* p = X + (size_t)(row0 + ai * 128 + m * 16) * D + col; f32x4 xv = *(f32x4*)p; xv += gv * (acc[ai][bj][m][n] + bv); *(f32x4*)p = xv; } }
  }
};
struct EpiGlu {
  static constexpr bool PERM = false, AFTER_DRAIN = false;
  float* X; const float* Xlat; const float* Xctx; const float* modl; const float* bias; int gi, pad_;
  __device__ __forceinline__ void operator()(const f32x4 (&acc)[2][2][4][2], const Unit& u, int wr, int wc, int fr, int fq) const {
    const int row0 = u.pm * 256 + wr * 64 + fr;
    const float* gate = modl + (size_t)stream_of_pm(u.pm) * NMOD + gi * D;
    const float* Xs = u.pm < ML / 256 ? Xlat : Xctx - (size_t)ML * D;
#pragma unroll
    for (int bj = 0; bj < 2; ++bj) { const int col = (u.pn * 8 + bj * 4 + wc) * 16 + 4 * fq;
      const f32x4 gv = *(const f32x4*)(gate + col), bv = *(const f32x4*)(bias + col), bg = *(const f32x4*)(bias + D + col);
#pragma unroll
      for (int ai = 0; ai < 2; ++ai)
#pragma unroll
        for (int m = 0; m < 4; ++m) { const size_t eo = (size_t)(row0 + ai * 128 + m * 16) * D + col; float* p = X + eo; f32x4 xv = *(const f32x4*)(Xs + eo);
          const f32x4 v = acc[ai][bj][m][0] + bv, g = acc[ai][bj][m][1] + bg;
#pragma unroll
          for (int j = 0; j < 4; ++j) xv[j] += gv[j] * v[j] * fsigmoid(g[j]);
          *(f32x4*)p = xv; } }
  }
};

template <class Epi> __device__ __forceinline__ void gemm_ph(int wv, pg8::Gemm g, Epi E) {
  __syncthreads();
  pg8::StaticOrder S; S.init(g.M, g.N, gridDim.x, blockIdx.x);
  pg8::gemm_phase<Epi, pg8::StaticOrder, false>((PG8_LAS unsigned char*)dyn_lds(), g, S, E, nullptr, wv);
  __syncthreads();
}
struct EpiPartial {
  static constexpr bool PERM = false, AFTER_DRAIN = false;
  float* P; int pad0_, pad1_;
  __device__ __forceinline__ void operator()(const f32x4 (&acc)[2][2][4][2], const Unit& u, int wr, int wc, int fr, int fq) const {
    const int row0 = (u.koff >> 10) * MC + u.pm * 256 + wr * 64 + fr, col0 = u.pn * 256 + wc * 32 + 4 * fq;
#pragma unroll
    for (int ai = 0; ai < 2; ++ai)
#pragma unroll
      for (int m = 0; m < 4; ++m) { float* rowp = P + (size_t)(row0 + ai * 128 + m * 16) * D + col0;
#pragma unroll
        for (int bj = 0; bj < 2; ++bj)
#pragma unroll
          for (int n = 0; n < 2; ++n) *(f32x4*)(rowp + bj * 128 + n * 16) = acc[ai][bj][m][n]; }
  }
};
__device__ __forceinline__ void gemm_ctx_splitk(int wv, const bf16_t* A, const bf16_t* Bt, int Ktot, EpiPartial E) {
  __syncthreads();
  pg8::Gemm g; g.A = A; g.Bt = Bt; g.M = MC; g.N = D; g.K = 512; g.ld = Ktot;
  pg8::SplitKOrder S; S.init(MC, D, Ktot / 512, 512, gridDim.x, blockIdx.x);
  pg8::gemm_phase<EpiPartial, pg8::SplitKOrder, false>((PG8_LAS unsigned char*)dyn_lds(), g, S, E, nullptr, wv);
  __syncthreads();
}
__device__ __forceinline__ pg8::Gemm mkg(const bf16_t* A, const bf16_t* Bt, int M, int N, int K) { pg8::Gemm g; g.A = A; g.Bt = Bt; g.M = M; g.N = N; g.K = K; g.ld = K; return g; }

struct Params {
  const float *x, *cvec, *ctx, *c_ctx, *ada_w, *ada_b, *norm_g, *final_g, *ffn_wg, *ffn_wu, *ffn_wd;
  const float *s5_a_re, *s5_a_im, *s5_log_dt, *s5_b_re, *s5_b_im, *s5_c_re, *s5_c_im, *s5_d, *s5_glu_w, *s5_glu_b;
  const float *hy_in_w, *hy_in_b, *hy_conv_w, *hy_conv_b, *hy_f_w1, *hy_f_b1, *hy_f_w2, *hy_f_b2, *hy_f_w3, *hy_f_b3, *hy_f_w4, *hy_f_freq, *hy_bias, *hy_out_w, *hy_out_b;
  const float *gdn_in_w, *gdn_conv_w, *gdn_a_log, *gdn_dt_bias, *gdn_norm_g, *gdn_out_w;
  float *out, *sv, *mod, *modp, *xb, *hb, *B1, *B2, *B3, *B4, *raw, *hdn3, *fnorm, *gg, *bt;
  bf16_t *hbb, *Ab, *Wgu, *Wd, *Wm1, *Wm2;
  unsigned* bar;
};
constexpr int LDS_WORK = 2 * FFT_BUF_BYTES + 256, LDS_TOTAL = LDS_WORK + 64;
static_assert(LDS_WORK >= 131072, "gemm stage");

template <int i> __device__ __forceinline__ void cvt_ffn_gu(int wv, const Params& p, int first) {
  k_cvt_t(wv, p.ffn_wg + (size_t)i * D * DFF, DFF, D, DFF, p.Wgu, 1, 0, first, 256 - first); k_cvt_t(wv, p.ffn_wu + (size_t)i * D * DFF, DFF, D, DFF, p.Wgu, 1, 16, first, 256 - first);
}
template <int i> __device__ __forceinline__ void cvt_ffn_d(int wv, const Params& p, int first) { k_cvt_t(wv, p.ffn_wd + (size_t)i * DFF * D, D, DFF, D, p.Wd, 0, 0, first, 256 - first); }
#define SYNC() xcd_barrier(bar, wv)
template <int i> __device__ __forceinline__ void layer(const Params& p, const XcdBarrier& bar, int wv) {
  {
    constexpr int kind = i % 3, j = i / 3, col_major = (j % 2) == 1;
    const float* modl = p.mod + (size_t)i * 3 * NMOD;
    Pend pd0 = {nullptr, nullptr, nullptr, 0};
    if constexpr (i > 0) pd0 = Pend{p.B4, p.mod + (size_t)(i - 1) * 3 * NMOD + (size_t)2 * NMOD + 5 * D, nullptr, DFF / 512};
    if constexpr (kind != 0) k_modnorm<(i > 0) ? DFF / 512 : 0>(wv, p.xb, p.norm_g + (size_t)(i * 2 + 0) * D, modl, 0, 1, nullptr, p.hbb, MT, pd0);
    if constexpr (kind == 0) {
      const size_t o1 = (size_t)j * 2 * G * P, o2 = (size_t)j * 2 * G, o3 = (size_t)j * 2 * G * P * HG;
      const float* gw = p.s5_glu_w + (size_t)j * D * 2 * D;
      bf16_t* UH = (bf16_t*)p.B2; bf16_t* Pt = (bf16_t*)(j == 0 ? p.B3 : p.hb); bf16_t* TQt = Pt + (size_t)G * 256 * 256;
      k_cvt_t(wv, gw, 2 * D, D, D, p.Wm1, 1, 0); k_cvt_t(wv, gw + D, 2 * D, D, D, p.Wm1, 1, 16);
      k_s5_modnorm<(i > 0) ? DFF / 512 : 0>(wv, i == 0 ? (float*)p.x : p.xb, i == 0 ? p.ctx : nullptr, p.norm_g + (size_t)(i * 2 + 0) * D, modl, UH, col_major, pd0);
      SYNC();
      k_s5_scanmm(wv, p.s5_a_re + o1, p.s5_a_im + o1, p.s5_log_dt + o2, Pt, UH);
      SYNC();
      k_s5_outmm(wv, TQt, UH, p.Ab, col_major);
      SYNC();
      { EpiGlu e = {p.xb, i == 0 ? p.x : p.xb, i == 0 ? p.ctx : p.xb + (size_t)ML * D, modl, p.s5_glu_b + (size_t)j * 2 * D, 2, 0}; gemm_ph<EpiGlu>(wv, mkg(p.Ab, p.Wm1, (i < DEPTH - 1) ? MT : ML, 2 * D, D), e); }
      if constexpr (i == 0) { cvt_ffn_gu<i>(wv, p, (MT / 256) * (2 * D / 256) % 256); cvt_ffn_d<i>(wv, p, (MT / 256) * (2 * D / 256) % 256); }
      SYNC();
    } else if constexpr (kind == 1) {
      float* uT = p.B1; float* zT = p.B4;
      k_cvt_t(wv, p.hy_in_w, 3 * D, D, 3 * D, p.Wm1, 0, 0); k_cvt_t(wv, p.hy_out_w, D, D, D, p.Wm2, 0, 0);
      k_hy_hdn(wv, p.hy_f_w1, p.hy_f_b1, p.hy_f_w2, p.hy_f_b2, p.hy_f_w3, p.hy_f_b3, p.hy_f_freq, p.hdn3);
      k_hy_w4prep(wv, p.hy_f_w4, (bf16_t*)p.B2);
      SYNC();
      { EpiFilt e = {p.raw, HY_RAW_LD, 0}; gemm_ph<EpiFilt>(wv, mkg((const bf16_t*)p.B2, (const bf16_t*)p.hdn3, 8192, HY_RAW_LD, 256), e); }
      { EpiStoreRowBias e = {uT, p.hy_in_b, MT, 0}; gemm_ph<EpiStoreRowBias>(wv, mkg(p.Wm1, p.hbb, 3 * D, MT, D), e); }
      cvt_ffn_gu<i>(wv, p, (3 * D / 256) * (MT / 256) % 256); cvt_ffn_d<i>(wv, p, (3 * D / 256) * (MT / 256) % 256);
      SYNC();
      k_hy_fftconv(wv, uT, p.raw, p.hy_conv_w, p.hy_conv_b, p.hy_bias, zT);
      SYNC();
      k_cvt_t(wv, zT, MT, D, MT, p.Ab, 0, 0);
      SYNC();
      { EpiResid e = {p.xb, modl, p.hy_out_b, 2, 0}; gemm_ph<EpiResid>(wv, mkg(p.Ab, p.Wm2, ML, D, D), e); }
      { EpiPartial e = {p.B4, 0, 0}; gemm_ctx_splitk(wv, p.Ab + (size_t)ML * D, p.Wm2, D, e); }
      SYNC();
    } else {
      bf16_t* proj = (bf16_t*)p.B1; float* gab = (float*)(proj + (size_t)MT * 12288); bf16_t* odir = (bf16_t*)p.B3;
      bf16_t* qn = (bf16_t*)p.B2; bf16_t* kn = qn + (size_t)MT * 2048; bf16_t* vv = kn + (size_t)MT * 2048; float* gcbuf = (float*)(vv + (size_t)MT * 4096);
      bf16_t* tinv = (bf16_t*)p.B4; bf16_t* attn = tinv + (size_t)GDN_ITEMS * 4096;
      k_cvt_t(wv, p.gdn_in_w, GDN_PROJ, D, GDN_PROJ, p.Wm1, 0, 0);
      k_zero_bf16(wv, p.Wm1 + (size_t)GDN_PROJ * D, (size_t)(GDN_LD - GDN_PROJ) * D);
      k_cvt_t(wv, p.gdn_out_w, D, GDN_V, D, p.Wm2, 0, 0);
      SYNC();
      { EpiProj e = {proj, gab}; gemm_ph<EpiProj>(wv, mkg(p.hbb, p.Wm1, MT, GDN_LD, D), e); }
      cvt_ffn_gu<i>(wv, p, (MT / 256) * (GDN_LD / 256) % 256);
      SYNC();
      k_gdn_feat(wv, proj, gab, p.gdn_conv_w, p.gdn_a_log, p.gdn_dt_bias, qn, kn, vv, p.gg, p.bt);
      SYNC();
      k_gdn_prep(wv, qn, kn, p.gg, p.bt, tinv, attn, gcbuf);
      SYNC();
      k_gdn_chain(wv, qn, kn, vv, p.bt, tinv, attn, gcbuf, odir);
      SYNC();
      k_gdn_gate2(wv, odir, proj, p.gdn_norm_g, p.Ab);
      SYNC();
      { EpiResid e = {p.xb, modl, nullptr, 2, 0}; gemm_ph<EpiResid>(wv, mkg(p.Ab, p.Wm2, ML, D, GDN_V), e); }
      { EpiPartial e = {p.B4, 0, 0}; gemm_ctx_splitk(wv, p.Ab + (size_t)ML * GDN_V, p.Wm2, GDN_V, e); }
      SYNC();
    }
    if constexpr (i == DEPTH - 1) cvt_ffn_gu<i>(wv, p, 0);
    Pend pd1 = {nullptr, nullptr, nullptr, 0};
    if constexpr (kind == 1) pd1 = Pend{p.B4, modl + (size_t)2 * NMOD + 2 * D, p.hy_out_b, D / 512};
    if constexpr (kind == 2) pd1 = Pend{p.B4, modl + (size_t)2 * NMOD + 2 * D, nullptr, GDN_V / 512};
    k_modnorm<kind == 1 ? D / 512 : (kind == 2 ? GDN_V / 512 : 0)>(wv, p.xb, p.norm_g + (size_t)(i * 2 + 1) * D, modl, 3, 4, nullptr, p.hbb, MT, pd1);
    SYNC();
    constexpr int MF = (i < DEPTH - 1) ? MT : ML;
    { EpiSwiglu e = {p.Ab, DFF, 0}; gemm_ph<EpiSwiglu>(wv, mkg(p.hbb, p.Wgu, MF, 2 * DFF, D), e); }
    if constexpr (i >= 2) cvt_ffn_d<i>(wv, p, (MF / 256) * (2 * DFF / 256) % 256);
    SYNC();
    { EpiResid e = {p.xb, modl, nullptr, 5, 0}; gemm_ph<EpiResid>(wv, mkg(p.Ab, p.Wd, ML, D, DFF), e); }
    if constexpr (i < DEPTH - 1) { EpiPartial e = {p.B4, 0, 0}; gemm_ctx_splitk(wv, p.Ab + (size_t)ML * DFF, p.Wd, DFF, e); }
    SYNC();
  }
}

__global__ __launch_bounds__(512, 2) void fwd(Params p) {
  extern __shared__ __attribute__((aligned(16))) unsigned char shm[];
  const int wv = __builtin_amdgcn_readfirstlane((int)threadIdx.x >> 6);
  volatile LAS unsigned* st = (volatile LAS unsigned*)(shm + LDS_WORK);
  if (threadIdx.x == 0) { st[0] = 0u; st[1] = 0u; st[2] = 0u; st[3] = 0u; }
  __syncthreads();
  XcdBarrier bar = xcd_barrier_post(p.bar, st);
  {
    S5W w0, w1;
    { const size_t o1 = 0, o2 = 0, o3 = 0; bf16_t* Pt = (bf16_t*)p.B3;
      w0 = S5W{p.s5_a_re + o1, p.s5_a_im + o1, p.s5_log_dt + o2, p.s5_b_re + o3, p.s5_b_im + o3, p.s5_c_re + o3, p.s5_c_im + o3, p.s5_d, Pt, Pt + (size_t)G * 256 * 256}; }
    { const size_t o1 = (size_t)2 * G * P, o2 = (size_t)2 * G, o3 = (size_t)2 * G * P * HG; bf16_t* Pt = (bf16_t*)p.hb;
      w1 = S5W{p.s5_a_re + o1, p.s5_a_im + o1, p.s5_log_dt + o2, p.s5_b_re + o3, p.s5_b_im + o3, p.s5_c_re + o3, p.s5_c_im + o3, p.s5_d + D, Pt, Pt + (size_t)G * 256 * 256}; }
    k_s5_ops(wv, w0, w1);
  }
  k_mod_partial(wv, p.cvec, p.c_ctx, p.ada_w, p.modp);
  SYNC();
  k_mod_reduce(wv, p.modp, p.ada_b, p.mod);
  SYNC();
  layer<0>(p, bar, wv); layer<1>(p, bar, wv); layer<2>(p, bar, wv); layer<3>(p, bar, wv);
  k_final(wv, p.xb, p.final_g, p.out, ML);
}
}

extern "C" void kernel_launch(void* const* d_in, const int* in_sizes, int n_in, void* d_out, int out_size, void* d_ws, size_t ws_size, hipStream_t stream) {
  Params p; memset(&p, 0, sizeof(p));
  const float** ins = (const float**)&p;
  for (int i = 0; i < 42; ++i) ins[i] = (const float*)d_in[i];
  p.out = (float*)d_out;
  float* ws = (float*)d_ws; size_t off = 0;
  auto take = [&](size_t n) { float* q = ws + off; off += (n + 63) & ~(size_t)63; return q; };
  auto takeb = [&](size_t n) { return (bf16_t*)take((n + 1) / 2); };
  p.bar = (unsigned*)take(XCD_BAR_WORDS);
  p.sv = take(3 * D);
  p.mod = take((size_t)DEPTH * 3 * NMOD);
  p.modp = take((size_t)MOD_NS * DEPTH * 3 * NMOD);
  p.xb = take((size_t)MT * D);
  p.hb = take((size_t)MT * D);
  p.hbb = takeb((size_t)MT * D);
  p.B1 = take((size_t)MT * GDN_LD);
  p.B2 = take((size_t)MT * GDN_CONV);
  p.B3 = take((size_t)2 * MT * GDN_V);
  p.B4 = take((size_t)MT * GDN_V);
  p.Ab = takeb((size_t)MT * DFF);
  p.raw = p.B1 + (size_t)MT * 3 * D;
  p.hdn3 = take((size_t)(SEQ + CTXL) * 128);
  p.fnorm = take(4 * D);
  p.gg = take((size_t)MT * 64);
  p.bt = take((size_t)MT * 64);
  p.Wgu = takeb((size_t)2 * DFF * D);
  p.Wd = takeb((size_t)D * DFF);
  p.Wm1 = takeb((size_t)GDN_LD * D);
  p.Wm2 = takeb((size_t)D * GDN_V);
  (void)ws_size; (void)n_in; (void)in_sizes; (void)out_size;
  static bool attr_done = false;
  if (!attr_done) { (void)hipFuncSetAttribute((const void*)fwd, hipFuncAttributeMaxDynamicSharedMemorySize, LDS_TOTAL); attr_done = true; }
  (void)hipMemsetAsync(p.bar, 0, XCD_BAR_WORDS * sizeof(unsigned), stream);
  hipLaunchKernelGGL(fwd, dim3(256), dim3(512), LDS_TOTAL, stream, p);
}
```

```cpp
#include <hip/hip_runtime.h>
#include <stdint.h>
#include <math.h>
#include <string.h>

__device__ __forceinline__ int lane_opq() { int l; asm volatile("v_mbcnt_lo_u32_b32 %0, -1, 0\n\tv_mbcnt_hi_u32_b32 %0, -1, %0" : "=v"(l)); return l; }
#define LDS_BARRIER() do { asm volatile("s_waitcnt lgkmcnt(0)" ::: "memory"); __builtin_amdgcn_s_barrier(); asm volatile("" ::: "memory"); } while (0)
namespace pg8 {
#define PG8_LAS __attribute__((address_space(3)))
typedef unsigned short bf16_t;
typedef short bf16x8 __attribute__((ext_vector_type(8)));
typedef float f32x4 __attribute__((ext_vector_type(4)));
typedef unsigned u32x4 __attribute__((ext_vector_type(4)));
constexpr int BM = 256, BK = 64, HALF = 128, HTB = HALF * BK * 2  , STAGE_BYTES = 8 * HTB, NXCD = 8, WGM = 8;

__host__ __device__ __forceinline__ int lds_byte(int r, int c) { const int st = (r >> 4) * 2 + (c >> 5), rr = r & 15, cc = c & 31, ob = rr * 64 + cc * 2; return st * 1024 + (ob ^ (((ob >> 9) & 1) << 5)); }
__host__ __device__ __forceinline__ void stage_rc(int b, int& R, int& C) { const int st = b / 1024, sb = b % 1024, swz = sb ^ (((sb >> 9) & 1) << 5); R = (st >> 1) * 16 + swz / 64; C = (st & 1) * 32 + (swz % 64) / 2; }
__host__ __device__ __forceinline__ int perm32(int rho) { const int n = rho >> 4, i = rho & 15; return 8 * (i >> 2) + 4 * n + (i & 3); }

struct Unit { int pm, pn, koff; };
struct Gemm { const bf16_t* A; const bf16_t* Bt; int M, N, K, ld; };

struct StaticOrder {
    int nM, nN, nwg, G, c;
    __host__ __device__ void init(int M, int N, int G_, int c_) { nM = M / BM; nN = N / BM; nwg = nM * nN; G = G_; c = c_; }
    __host__ __device__ bool next(int i, Unit& u) const {
        const long L = (long)i * G + c; if (L >= nwg) return false;
        int wgid = (int)L; { const int q = nwg / NXCD, r = nwg % NXCD, xcd = wgid % NXCD, off = wgid / NXCD; wgid = (xcd < r ? xcd * (q + 1) : r * (q + 1) + (xcd - r) * q) + off; }
        const int nig = WGM * nN, gid = wgid / nig, fm = gid * WGM, gsz = (nM - fm) < WGM ? (nM - fm) : WGM;
        u.pm = fm + ((wgid % nig) % gsz); u.pn = (wgid % nig) / gsz; u.koff = 0; return true;
    }
    __device__ __forceinline__ void a_ready(const Unit&) const {}
    __device__ __forceinline__ void done(const Unit&) const {}
};
struct SplitKOrder {
    int nN, nS, nwg, G, c, ksb;
    __device__ void init(int M, int N, int nS_, int kslice, int G_, int c_) { nN = N / BM; nS = nS_; nwg = (M / BM) * nN * nS; G = G_; c = c_; ksb = kslice * 2; }
    __device__ bool next(int i, Unit& u) const { const int L = i * G + c; if (L >= nwg) return false; const int sl = L % nS, tile = L / nS; u.pn = tile % nN; u.pm = tile / nN; u.koff = sl * ksb; return true; }
    __device__ __forceinline__ void a_ready(const Unit&) const {}
    __device__ __forceinline__ void done(const Unit&) const {}
};
typedef float cvt_f2_t __attribute__((ext_vector_type(2))); typedef __bf16 cvt_b2_t __attribute__((ext_vector_type(2)));
__device__ __forceinline__ unsigned cvt_pk_bf16(float lo, float hi) { const cvt_f2_t v = {lo, hi}; return __builtin_bit_cast(unsigned, __builtin_convertvector(v, cvt_b2_t)); }

template <class Epi, class Sched, bool STAMP = false>
__device__ __forceinline__ void gemm_phase(PG8_LAS unsigned char* lds, const Gemm g, const Sched& S, const Epi& E, unsigned long long* stamps, int wv) {
    int tid = wv * 64 + lane_opq(); asm volatile("" : "+v"(tid));
    const int wid = __builtin_amdgcn_readfirstlane(tid >> 6), lane = tid & 63, wr = wid >> 2, wc = wid & 3, fr = lane & 15, fq = lane >> 4;
    const int K = g.K, nt = K / BK, ld = g.ld;
    int ts_lo = 0, ts_hi = 0, nts = 0; const unsigned long long rt_entry = STAMP ? (unsigned long long)wall_clock64() : 0ull;
#define PG8_STAMP() do { if (STAMP && wid == 0 && nts < 64) { const unsigned long long _c = (unsigned long long)clock64(); \
        ts_lo = (lane == nts) ? (int)(unsigned)_c : ts_lo; ts_hi = (lane == nts) ? (int)(unsigned)(_c >> 32) : ts_hi; ++nts; } } while (0)
    PG8_STAMP();
    unsigned voffA[2], voffB[2];
#pragma unroll
    for (int i = 0; i < 2; ++i) { int R, C; stage_rc(tid * 16 + i * 8192, R, C); const int Rb = Epi::PERM ? ((R & ~31) + perm32(R & 31)) : R;
        voffA[i] = (unsigned)(R * ld + C) * 2u; voffB[i] = (unsigned)(Rb * ld + C) * 2u; }
    const size_t kstep = (size_t)(BK * 2);
    const size_t hstep = (size_t)HALF * ld * 2;
    const size_t tstep = 2 * hstep;
    const unsigned ldsw = (unsigned)wid * 1024u;
    const int aoff = lds_byte(wr * 64 + fr, fq * 8), boff = lds_byte(wc * 32 + fr, fq * 8);
#define PG8_SA(b, h) (((b) * 2 + (h)) * HTB)
#define PG8_SB(b, h) ((4 + (b) * 2 + (h)) * HTB)
#define PG8_STAGE(bufoff, gbase, voff) do { _Pragma("unroll") for (int _i = 0; _i < 2; ++_i) \
        __builtin_amdgcn_global_load_lds((const unsigned*)((const char*)(gbase) + (voff)[_i]), (PG8_LAS unsigned*)(lds + (bufoff) + ldsw + _i * 8192), 16, 0, 0); } while (0)
#define PG8_LDA(dst, b, h) do { _Pragma("unroll") for (int m = 0; m < 4; ++m) _Pragma("unroll") for (int k = 0; k < 2; ++k) dst[m][k] = *(const PG8_LAS bf16x8*)(lds + PG8_SA(b, h) + aoff + m * 2048 + k * 1024); } while (0)
#define PG8_LDB(dst, b, h) do { _Pragma("unroll") for (int n = 0; n < 2; ++n) _Pragma("unroll") for (int k = 0; k < 2; ++k) dst[n][k] = *(const PG8_LAS bf16x8*)(lds + PG8_SB(b, h) + boff + n * 2048 + k * 1024); } while (0)
#define PG8_MMA(ai, bj, At, Bt) do { __builtin_amdgcn_s_setprio(1); _Pragma("unroll") for (int m = 0; m < 4; ++m) _Pragma("unroll") for (int n = 0; n < 2; ++n) _Pragma("unroll") for (int k = 0; k < 2; ++k) \
        acc[ai][bj][m][n] = __builtin_amdgcn_mfma_f32_16x16x32_bf16(Bt[n][k], At[m][k], acc[ai][bj][m][n], 0, 0, 0); __builtin_amdgcn_s_setprio(0); } while (0)
#define PG8_WAIT_V(n) asm volatile("s_waitcnt vmcnt(" #n ")" ::: "memory")
#define PG8_WAIT_L(n) asm volatile("s_waitcnt lgkmcnt(" #n ")" ::: "memory")
#define PG8_BAR __builtin_amdgcn_s_barrier()
#define PG8_SCHED __builtin_amdgcn_sched_barrier(0)
    Unit cur, nxt; int ui = 0;
    if (!S.next(0, cur)) return;
    f32x4 acc[2][2][4][2];
#pragma unroll
    for (int a = 0; a < 2; ++a)
#pragma unroll
        for (int b = 0; b < 2; ++b)
#pragma unroll
            for (int m = 0; m < 4; ++m)
#pragma unroll
                for (int n = 0; n < 2; ++n) acc[a][b][m][n] = (f32x4){0.f, 0.f, 0.f, 0.f};
    bf16x8 At[4][2], B0[2][2], B1[2][2];
    const char* cA = (const char*)g.A + (size_t)cur.pm * tstep + cur.koff; const char* cB = (const char*)g.Bt + (size_t)cur.pn * tstep + cur.koff;
    S.a_ready(cur);
    PG8_STAGE(PG8_SB(0, 0), cB, voffB); PG8_STAGE(PG8_SA(0, 0), cA, voffA); PG8_STAGE(PG8_SB(0, 1), cB + hstep, voffB); PG8_STAGE(PG8_SA(0, 1), cA + hstep, voffA);
    if (wr == 1) PG8_BAR;
    PG8_WAIT_V(4); PG8_BAR;
    PG8_STAGE(PG8_SB(1, 0), cB + kstep, voffB); PG8_STAGE(PG8_SA(1, 0), cA + kstep, voffA); PG8_STAGE(PG8_SB(1, 1), cB + hstep + kstep, voffB);
    PG8_WAIT_V(6); PG8_BAR;
    PG8_STAMP();
    for (;;) {
        const bool has_next = S.next(ui + 1, nxt);
        const char* nA = has_next ? (const char*)g.A + (size_t)nxt.pm * tstep + nxt.koff : cA; const char* nB = has_next ? (const char*)g.Bt + (size_t)nxt.pn * tstep + nxt.koff : cB;
        for (int t = 0; t < nt; t += 2) {
            const bool last = (t == nt - 2);
            const char* a1 = cA + (size_t)(t + 1) * kstep;
            const char* a2 = last ? nA : cA + (size_t)(t + 2) * kstep; const char* b2 = last ? nB : cB + (size_t)(t + 2) * kstep;
            const char* a3 = a2 + kstep; const char* b3 = b2 + kstep;
            if (last && has_next) S.a_ready(nxt);
            PG8_LDB(B0, 0, 0); PG8_SCHED; PG8_LDA(At, 0, 0); PG8_STAGE(PG8_SA(1, 1), a1 + hstep, voffA);
            PG8_WAIT_L(8); PG8_BAR; PG8_WAIT_L(0); PG8_MMA(0, 0, At, B0); PG8_BAR; PG8_SCHED;
            PG8_LDB(B1, 0, 1); PG8_STAGE(PG8_SB(0, 0), b2, voffB);
            PG8_BAR; PG8_WAIT_L(0); PG8_MMA(0, 1, At, B1); PG8_BAR;
            PG8_LDA(At, 0, 1); PG8_STAGE(PG8_SA(0, 0), a2, voffA);
            PG8_BAR; PG8_WAIT_L(0); PG8_MMA(1, 0, At, B0); PG8_BAR; PG8_SCHED;
            PG8_STAGE(PG8_SB(0, 1), b2 + hstep, voffB);
            PG8_WAIT_V(6); PG8_BAR; PG8_MMA(1, 1, At, B1); PG8_BAR;
            PG8_LDB(B0, 1, 0); PG8_SCHED; PG8_LDA(At, 1, 0); PG8_STAGE(PG8_SA(0, 1), a2 + hstep, voffA);
            PG8_WAIT_L(8); PG8_BAR; PG8_WAIT_L(0); PG8_MMA(0, 0, At, B0); PG8_BAR; PG8_SCHED;
            PG8_LDB(B1, 1, 1); PG8_STAGE(PG8_SB(1, 0), b3, voffB);
            PG8_BAR; PG8_WAIT_L(0); PG8_MMA(0, 1, At, B1); PG8_BAR;
            PG8_LDA(At, 1, 1); PG8_STAGE(PG8_SA(1, 0), a3, voffA);
            PG8_BAR; PG8_WAIT_L(0); PG8_MMA(1, 0, At, B0); PG8_BAR; PG8_SCHED;
            PG8_STAGE(PG8_SB(1, 1), b3 + hstep, voffB);
            PG8_WAIT_V(6); PG8_BAR; PG8_MMA(1, 1, At, B1); PG8_BAR;
        }
        PG8_STAMP();
        if constexpr (!Epi::AFTER_DRAIN) { E(acc, cur, wr, wc, fr, fq); S.done(cur); }
        PG8_STAMP();
        if (!has_next) break;
#pragma unroll
        for (int a = 0; a < 2; ++a)
#pragma unroll
            for (int b = 0; b < 2; ++b)
#pragma unroll
                for (int m = 0; m < 4; ++m)
#pragma unroll
                    for (int n = 0; n < 2; ++n) acc[a][b][m][n] = (f32x4){0.f, 0.f, 0.f, 0.f};
        cur = nxt; cA = nA; cB = nB; ++ui;
    }
    PG8_WAIT_V(0);
    if (wr == 0) PG8_BAR;
    PG8_BAR;
    if constexpr (Epi::AFTER_DRAIN) { E.fused(acc, cur, wr, wc, fr, fq, lds, wid, lane); S.done(cur); }
    PG8_STAMP();
    if (STAMP && wid == 0) { stamps[lane] = lane < nts ? (((unsigned long long)(unsigned)ts_hi << 32) | (unsigned)ts_lo) : 0ull;
        if (lane == 62) stamps[62] = rt_entry; if (lane == 63) stamps[63] = (unsigned long long)wall_clock64(); }
#undef PG8_STAMP
#undef PG8_SA
#undef PG8_SB
#undef PG8_STAGE
#undef PG8_LDA
#undef PG8_LDB
#undef PG8_MMA
#undef PG8_WAIT_V
#undef PG8_WAIT_L
#undef PG8_BAR
#undef PG8_SCHED
}
}

#define XB_TMO      128
#define XB_XCNT(j)  (256  + 64 * (j))
#define XB_XSUB(j)  (1280 + 64 * (j))
#define XB_XGEN(j)  (2304 + 64 * (j))
#define XB_TOP      3328
#define XB_TOPGEN   3392
#define XCD_BAR_WORDS 3456
#define XB_SPIN_CAP (1u << 22)
#define LAS __attribute__((address_space(3)))

__device__ __forceinline__ unsigned xb_ld(unsigned* p)              { return __hip_atomic_load(p, __ATOMIC_RELAXED, __HIP_MEMORY_SCOPE_AGENT); }
__device__ __forceinline__ unsigned xb_add(unsigned* p, unsigned v) { return __hip_atomic_fetch_add(p, v, __ATOMIC_RELAXED, __HIP_MEMORY_SCOPE_AGENT); }
__device__ __forceinline__ unsigned xb_xcc_id() { return (unsigned)__builtin_amdgcn_s_getreg((3 << 11) | 20) & 0xFu; }
#define XB_SPIN(cond, bar) do { unsigned _sp = 0; while (cond) { __builtin_amdgcn_s_sleep(1); \
    if ((++_sp & 255u) == 0u) { if (xb_ld(&(bar)[XB_TMO])) break; if (_sp > XB_SPIN_CAP) { atomicAdd(&(bar)[XB_TMO], 1u); break; } } } } while (0)

struct XcdBarrier {
    unsigned* bar; unsigned x;
    volatile LAS unsigned* st;
};

__device__ __forceinline__ XcdBarrier xcd_barrier_post(unsigned* bar, volatile LAS unsigned* st) {
    XcdBarrier b; b.bar = bar; b.x = xb_xcc_id(); b.st = st;
    if (threadIdx.x == 0) (void)xb_add(&bar[XB_XCNT(b.x)], 1u);
    return b;
}
__device__ __forceinline__ void xcd_barrier_complete(unsigned* bar, unsigned x, unsigned& nloc, unsigned& nx) {
    const unsigned G = gridDim.x * gridDim.y * gridDim.z;
    unsigned sum, cnt, mine, sp = 0u;
    for (;;) {
        sum = 0u; cnt = 0u; mine = 0u;
#pragma unroll
        for (unsigned j = 0; j < 16; ++j) { const unsigned c = xb_ld(&bar[XB_XCNT(j)]); sum += c; cnt += (c > 0u) ? 1u : 0u; mine = (j == x) ? c : mine; }
        if (sum == G) break;
        __builtin_amdgcn_s_sleep(1);
        if ((++sp & 255u) == 0u) { if (xb_ld(&bar[XB_TMO])) break; if (sp > XB_SPIN_CAP) { atomicAdd(&bar[XB_TMO], 1u); break; } }
    }
    nloc = mine > 0u ? mine : 1u; nx = cnt > 0u ? cnt : 1u;
}

__device__ __forceinline__ void xcd_barrier(const XcdBarrier& b, int wv) {
    asm volatile("s_waitcnt vmcnt(0)" ::: "memory");
    __syncthreads();
    if (wv * 64 + lane_opq() == 0) {
        unsigned* bar = b.bar;
        __builtin_amdgcn_s_waitcnt(0);
        unsigned nloc = b.st[0], nx = b.st[1];
        if (nloc == 0u) { xcd_barrier_complete(bar, b.x, nloc, nx); b.st[0] = nloc; b.st[1] = nx; }
        const unsigned old = xb_add(&bar[XB_XSUB(b.x)], 1u);
        const unsigned gen = old / nloc;
        if (old + 1u == (gen + 1u) * nloc) {
            __builtin_amdgcn_fence(__ATOMIC_RELEASE, "agent");
            asm volatile("s_waitcnt vmcnt(0)" ::: "memory");
            const unsigned og = xb_add(&bar[XB_TOP], 1u);
            const unsigned tg = og / nx;
            if (og + 1u == (tg + 1u) * nx) xb_add(&bar[XB_TOPGEN], 1u);
            else XB_SPIN(xb_ld(&bar[XB_TOPGEN]) == tg, bar);
            __builtin_amdgcn_fence(__ATOMIC_ACQUIRE, "agent");
            xb_add(&bar[XB_XGEN(b.x)], 1u);
            asm volatile("s_waitcnt vmcnt(0)" ::: "memory");
        } else {
            XB_SPIN(xb_ld(&bar[XB_XGEN(b.x)]) == gen, bar);
            __builtin_amdgcn_fence(__ATOMIC_ACQUIRE, "agent");
            asm volatile("s_waitcnt vmcnt(0)" ::: "memory");
        }
    }
    __syncthreads();
}


namespace {
constexpr int D = 2048, NBATCH = 2, SEQ = 4096, CTXL = 256, DEPTH = 4, DFF = 5632;
constexpr int ML = NBATCH * SEQ, MC = NBATCH * CTXL, MT = ML + MC;
constexpr int G = 128, P = 64, HG = 16;
constexpr int NMOD = 6 * D;
using pg8::bf16_t; using pg8::f32x4; using pg8::Unit;
typedef unsigned u32x2 __attribute__((ext_vector_type(2)));
__device__ __forceinline__ bf16_t f2bf(float f) { return __builtin_bit_cast(unsigned short, (__bf16)f); }
using pg8::bf16x8;
__device__ __forceinline__ float fsilu(float x) { return x * __builtin_amdgcn_rcpf(1.0f + __expf(-x)); }
__device__ __forceinline__ float fsigmoid(float x) { return __builtin_amdgcn_rcpf(1.0f + __expf(-x)); }
constexpr int GDN_PROJ = 12416, GDN_LD = 12544, GDN_CONV = 8192, GDN_V = 4096;

__device__ __forceinline__ int otid(int wv) { int t = wv * 64 + lane_opq(); asm volatile("" : "+v"(t)); return t; }
__device__ __forceinline__ unsigned char* dyn_lds() { extern __shared__ __attribute__((aligned(16))) unsigned char shm_[]; return shm_; }
__device__ __forceinline__ float silu_f(float x) { return x / (1.0f + expf(-x)); }
__device__ __forceinline__ float sigmoid_f(float x) { return 1.0f / (1.0f + expf(-x)); }
__device__ __forceinline__ float gelu_tanh_f(float x) { return 0.5f * x * (1.0f + tanhf(0.7978845608028654f * (x + 0.044715f * x * x * x))); }
__device__ __forceinline__ int stream_of(int row) { return row < ML ? row / SEQ : 2; }
__device__ __forceinline__ float wave_sum(float v) {
  int l = lane_opq(); asm volatile("" : "+v"(l));
#pragma unroll
  for (int o = 32; o > 0; o >>= 1) v += __int_as_float(__builtin_amdgcn_ds_bpermute((l ^ o) << 2, __float_as_int(v)));
  return v;
}
__device__ __forceinline__ float block_sum(float v, float* red, int tid_) {
  v = wave_sum(v);
  const int w = tid_ >> 6, nw = blockDim.x >> 6;
  __syncthreads();
  if ((tid_ & 63) == 0) red[w] = v;
  __syncthreads();
  float s = 0.f;
  for (int i = 0; i < nw; ++i) s += red[i];
  return s;
}

__device__ __forceinline__ void k_silu_vec(int wv, const float* c, const float* cctx, float* sv) {
  for (int i = blockIdx.x * blockDim.x + otid(wv); i < 3 * D; i += gridDim.x * blockDim.x)
    sv[i] = i < 2 * D ? silu_f(c[i]) : silu_f(cctx[i - 2 * D]);
}
constexpr int MOD_KS = 64, MOD_NS = D / MOD_KS;
__device__ __forceinline__ void k_mod_partial(int wv, const float* __restrict__ cvec, const float* __restrict__ cctx, const float* __restrict__ ada_w, float* __restrict__ modp) {
  const int lane = lane_opq();
  const int nwave = gridDim.x * 8, wave = wv * gridDim.x + blockIdx.x;
  for (int item = wave; item < DEPTH * MOD_NS * (NMOD / 256); item += nwave) {
    const int cc = item % (NMOD / 256), sl = (item / (NMOD / 256)) % MOD_NS, i = item / ((NMOD / 256) * MOD_NS);
    const int col = cc * 256 + lane * 4, k0 = sl * MOD_KS;
    const float* W = ada_w + ((size_t)i * D + k0) * NMOD + col;
    f32x4 a0 = {0.f, 0.f, 0.f, 0.f}, a1 = a0, a2 = a0;
    const float sv0 = silu_f(cvec[k0 + lane]), sv1 = silu_f(cvec[D + k0 + lane]), sv2 = silu_f(cctx[k0 + lane]);
#pragma unroll 8
    for (int k = 0; k < MOD_KS; ++k) { const f32x4 w = *(const f32x4*)(W + (size_t)k * NMOD);
      a0 += w * __int_as_float(__builtin_amdgcn_readlane(__float_as_int(sv0), k)); a1 += w * __int_as_float(__builtin_amdgcn_readlane(__float_as_int(sv1), k)); a2 += w * __int_as_float(__builtin_amdgcn_readlane(__float_as_int(sv2), k)); }
    float* o = modp + ((size_t)(sl * DEPTH + i) * 3) * NMOD + col;
    *(f32x4*)(o) = a0; *(f32x4*)(o + NMOD) = a1; *(f32x4*)(o + 2 * NMOD) = a2;
  }
}
__device__ __forceinline__ void k_mod_reduce(int wv, const float* __restrict__ modp, const float* __restrict__ ada_b, float* __restrict__ mod) {
  int tid_ = otid(wv);
  for (int idx = blockIdx.x * 512 + tid_; idx < DEPTH * 3 * NMOD; idx += gridDim.x * 512) {
    const int n = idx % NMOD, i = idx / (3 * NMOD);
    float a = ada_b[i * NMOD + n];
#pragma unroll 8
    for (int sl = 0; sl < MOD_NS; ++sl) a += modp[(size_t)sl * DEPTH * 3 * NMOD + idx];
    mod[idx] = a;
  }
}
struct Pend { const float* P; const float* gate; const float* bias; int nS; };
template <int NS> __device__ __forceinline__ void k_modnorm(int wv, float* src, const float* g, const float* modl, int shi, int sci, float* dst, unsigned short* dstb, int M, Pend pd) {
  const int lane = lane_opq();
  const int nwave = gridDim.x * 8, wave = wv * gridDim.x + blockIdx.x;
  for (int row = wave; row < M; row += nwave) {
    const int r = stream_of(row);
    float* x = src + (size_t)row * D + lane * 4;
    f32x4 xv[8];
#pragma unroll
    for (int q = 0; q < 8; ++q) xv[q] = *(const f32x4*)(x + 256 * q);
    if (NS > 0 && row >= ML) {
#pragma unroll
      for (int q = 0; q < 8; ++q) { f32x4 pv[NS > 0 ? NS : 1];
#pragma unroll
        for (int sl = 0; sl < NS; ++sl) pv[sl] = *(const f32x4*)(pd.P + ((size_t)sl * MC + (row - ML)) * D + lane * 4 + 256 * q);
        f32x4 a = {0.f, 0.f, 0.f, 0.f}; if (pd.bias) a = *(const f32x4*)(pd.bias + lane * 4 + 256 * q);
#pragma unroll
        for (int sl = 0; sl < NS; ++sl) a += pv[sl];
        xv[q] += *(const f32x4*)(pd.gate + lane * 4 + 256 * q) * a; *(f32x4*)(x + 256 * q) = xv[q]; }
    }
    float ss = 0.f;
#pragma unroll
    for (int q = 0; q < 8; ++q) ss += xv[q][0] * xv[q][0] + xv[q][1] * xv[q][1] + xv[q][2] * xv[q][2] + xv[q][3] * xv[q][3];
    ss = wave_sum(ss);
    const float rstd = rsqrtf(ss / D + 1e-6f);
    const float* sh = modl + (size_t)r * NMOD + shi * D + lane * 4; const float* sc = modl + (size_t)r * NMOD + sci * D + lane * 4; const float* gn = g + lane * 4;
#pragma unroll
    for (int q = 0; q < 8; ++q) { const f32x4 gv = *(const f32x4*)(gn + 256 * q), scv = *(const f32x4*)(sc + 256 * q), shv = *(const f32x4*)(sh + 256 * q);
      f32x4 h;
#pragma unroll
      for (int jj = 0; jj < 4; ++jj) h[jj] = xv[q][jj] * rstd * gv[jj] * (1.0f + scv[jj]) + shv[jj];
      if (dst) *(f32x4*)(dst + (size_t)row * D + lane * 4 + 256 * q) = h;
      if (dstb) *(u32x2*)(dstb + (size_t)row * D + lane * 4 + 256 * q) = (u32x2){pg8::cvt_pk_bf16(h[0], h[1]), pg8::cvt_pk_bf16(h[2], h[3])}; }
  }
}
__device__ __forceinline__ void k_final(int wv, const float* src, const float* g, float* dst, int M) {
  const int lane = lane_opq();
  const int nwave = gridDim.x * 8, wave = wv * gridDim.x + blockIdx.x;
  for (int row = wave; row < M; row += nwave) {
    const float* x = src + (size_t)row * D + lane * 4;
    f32x4 xv[8]; float ss = 0.f;
#pragma unroll
    for (int q = 0; q < 8; ++q) { xv[q] = *(const f32x4*)(x + 256 * q); ss += xv[q][0] * xv[q][0] + xv[q][1] * xv[q][1] + xv[q][2] * xv[q][2] + xv[q][3] * xv[q][3]; }
    ss = wave_sum(ss);
    const float rstd = rsqrtf(ss / D + 1e-6f);
#pragma unroll
    for (int q = 0; q < 8; ++q) { const f32x4 gv = *(const f32x4*)(g + lane * 4 + 256 * q); *(f32x4*)(dst + (size_t)row * D + lane * 4 + 256 * q) = xv[q] * rstd * gv; }
  }
}
__device__ __forceinline__ void k_copy_x(int wv, const float* x, const float* ctx, float* xb) {
  int tid_ = otid(wv);
  const size_t n = (size_t)MT * D;
  for (size_t i = (size_t)blockIdx.x * blockDim.x + tid_; i < n; i += (size_t)gridDim.x * blockDim.x)
    xb[i] = i < (size_t)ML * D ? x[i] : ctx[i - (size_t)ML * D];
}

__device__ __forceinline__ void k_resid(int wv, float* x, const float* y, int ldy, const float* modl, int gi, int M) {
  int tid_ = otid(wv);
  const size_t n = (size_t)M * D;
  for (size_t i = (size_t)blockIdx.x * blockDim.x + tid_; i < n; i += (size_t)gridDim.x * blockDim.x) {
    const int row = (int)(i / D), c = (int)(i % D), r = stream_of(row);
    x[i] += modl[(size_t)r * NMOD + gi * D + c] * y[(size_t)row * ldy + c];
  }
}
__device__ __forceinline__ void k_resid_glu(int wv, float* x, const float* gz, const float* modl, int gi, int M) {
  int tid_ = otid(wv);
  const size_t n = (size_t)M * D;
  for (size_t i = (size_t)blockIdx.x * blockDim.x + tid_; i < n; i += (size_t)gridDim.x * blockDim.x) {
    const int row = (int)(i / D), c = (int)(i % D), r = stream_of(row);
    const float a = gz[(size_t)row * 2 * D + c], b = gz[(size_t)row * 2 * D + D + c];
    x[i] += modl[(size_t)r * NMOD + gi * D + c] * (a * sigmoid_f(b));
  }
}
__device__ __forceinline__ void k_swiglu(int wv, const float* g, const float* u, float* act, size_t n) {
  int tid_ = otid(wv);
  for (size_t i = (size_t)blockIdx.x * blockDim.x + tid_; i < n; i += (size_t)gridDim.x * blockDim.x) act[i] = silu_f(g[i]) * u[i];
}

__device__ __forceinline__ void k_s5_scan(int wv, const float* __restrict__ h, const float* a_re, const float* a_im, const float* log_dt, const float* b_re, const float* b_im,
                          const float* c_re, const float* c_im, float* ydir, int col_major) {
  int tid_ = otid(wv);
  const int lane = tid_ & 63, wave = (tid_ >> 6) * gridDim.x + blockIdx.x, nw = (gridDim.x * blockDim.x) >> 6;
  for (int item = wave; item < NBATCH * G * 2; item += nw) {
    const int dir = item & 1, g = (item >> 1) % G, b = item / (2 * G);
    const int p = lane, gp = (dir * G + g) * P + p;
    const float are = a_re[gp], aim = a_im[gp], dt = expf(log_dt[dir * G + g]);
    const float mag = expf(are * dt), lr = mag * cosf(aim * dt), li = mag * sinf(aim * dt);
    const float nr = lr - 1.0f, ni = li, den = are * are + aim * aim;
    const float qr = (nr * are + ni * aim) / den, qi = (ni * are - nr * aim) / den;
    float Br[16], Bi[16], Cr[16], Ci[16];
#pragma unroll
    for (int c = 0; c < 16; ++c) { const float br = b_re[(size_t)gp * 16 + c], bi = b_im[(size_t)gp * 16 + c]; Br[c] = qr * br - qi * bi; Bi[c] = qr * bi + qi * br; }
#pragma unroll
    for (int i = 0; i < 16; ++i) { Cr[i] = c_re[((size_t)(dir * G + g) * 16 + i) * P + p]; Ci[i] = c_im[((size_t)(dir * G + g) * 16 + i) * P + p]; }
    float hr = 0.f, hi = 0.f;
    for (int s = 0; s < CTXL + SEQ; ++s) {
      int row;
      if (s < CTXL) { const int t = dir ? CTXL - 1 - s : s; row = ML + b * CTXL + t; }
      else { int q = s - CTXL; if (dir) q = SEQ - 1 - q; const int t = col_major ? ((q & 63) * 64 + (q >> 6)) : q; row = b * SEQ + t; }
      const float* u = h + (size_t)row * D + g * 16;
      float ur = 0.f, ui = 0.f;
#pragma unroll
      for (int c = 0; c < 16; ++c) { const float uc = u[c]; ur += Br[c] * uc; ui += Bi[c] * uc; }
      const float nhr = lr * hr - li * hi + ur, nhi = lr * hi + li * hr + ui;
      hr = nhr; hi = nhi;
      float outv = 0.f;
#pragma unroll
      for (int i = 0; i < 16; ++i) { float v = Cr[i] * hr - Ci[i] * hi; v = wave_sum(v); if (lane == i) outv = v; }
      if (lane < 16) ydir[((size_t)dir * MT + row) * D + g * 16 + lane] = outv;
    }
  }
}
__device__ __forceinline__ void k_s5_gelu(int wv, const float* h, const float* dvec, const float* ydir, unsigned short* z) {
  int tid_ = otid(wv);
  const size_t n = (size_t)MT * D;
  for (size_t i = (size_t)blockIdx.x * blockDim.x + tid_; i < n; i += (size_t)gridDim.x * blockDim.x) {
    const int c = (int)(i % D);
    const float v = gelu_tanh_f(h[i] * dvec[c] + ydir[i] + ydir[n + i]);
    unsigned uu = __float_as_uint(v); uu += 0x7FFFu + ((uu >> 16) & 1u); z[i] = (unsigned short)(uu >> 16);
  }
}

__device__ __forceinline__ double dsin_red(double x) {
  const double k = rint(x * 0.15915494309189535);
  const double r = x - k * 6.283185307179586;
  return (double)sinf((float)r);
}
__device__ __forceinline__ void k_hy_hdn(int wv, const float* w1, const float* b1, const float* w2, const float* b2, const float* w3, const float* b3, const float* freq, float* hdn3) {
  int tid_ = otid(wv);
  double (*sh)[64] = (double (*)[64])dyn_lds();
  __syncthreads();
  const int lane = tid_ & 63, wl = tid_ >> 6;
  float* W1s = (float*)(dyn_lds() + 4096); float* W2s = W1s + 33 * 64; float* W3s = W2s + 64 * 64;
  for (int e = tid_; e < 33 * 64; e += 512) W1s[e] = w1[e];
  for (int e = tid_; e < 64 * 64; e += 512) { W2s[e] = w2[e]; W3s[e] = w3[e]; }
  __syncthreads();
  for (int tb = blockIdx.x * 8; tb < SEQ + CTXL; tb += gridDim.x * 8) {
    const int tt = tb + wl;
    const int n = tt < SEQ ? SEQ : CTXL, t = tt < SEQ ? tt : tt - SEQ;
    const double t_unit = (double)t / (double)(n - 1);
    const double fq = (double)freq[lane];
    double a = (double)b1[lane] + t_unit * (double)W1s[lane];
#pragma unroll
    for (int kb = 0; kb < 16; ++kb) {
      const double band = 1e-4 + (15.0 - 1e-4) * (double)kb / 15.0;
      double fr = (double)t * band / (double)n; fr -= floor(fr);
      const float ang = (float)(2.0 * M_PI * fr);
      a += (double)cosf(ang) * (double)W1s[(1 + kb) * 64 + lane] - (double)sinf(ang) * (double)W1s[(17 + kb) * 64 + lane];
    }
    double hcur = dsin_red(fq * a);
    sh[wl][lane] = hcur; __syncthreads();
    a = (double)b2[lane];
    { double a1 = 0.0, a2 = 0.0, a3 = 0.0;
#pragma unroll
      for (int e = 0; e < 64; e += 4) { a += sh[wl][e] * (double)W2s[(e) * 64 + lane]; a1 += sh[wl][e + 1] * (double)W2s[(e + 1) * 64 + lane]; a2 += sh[wl][e + 2] * (double)W2s[(e + 2) * 64 + lane]; a3 += sh[wl][e + 3] * (double)W2s[(e + 3) * 64 + lane]; }
      a = (a + a1) + (a2 + a3); }
    hcur = dsin_red(fq * a);
    __syncthreads(); sh[wl][lane] = hcur; __syncthreads();
    a = (double)b3[lane];
    { double a1 = 0.0, a2 = 0.0, a3 = 0.0;
#pragma unroll
      for (int e = 0; e < 64; e += 4) { a += sh[wl][e] * (double)W3s[(e) * 64 + lane]; a1 += sh[wl][e + 1] * (double)W3s[(e + 1) * 64 + lane]; a2 += sh[wl][e + 2] * (double)W3s[(e + 2) * 64 + lane]; a3 += sh[wl][e + 3] * (double)W3s[(e + 3) * 64 + lane]; }
      a = (a + a1) + (a2 + a3); }
    hcur = dsin_red(fq * a);
    __syncthreads();
    { const float hf = (float)hcur; const bf16_t hi = f2bf(hf); const bf16_t lo = f2bf(hf - __uint_as_float(((unsigned)hi) << 16));
      bf16_t* o = (bf16_t*)hdn3 + (size_t)tt * 256; o[lane] = hi; o[64 + lane] = hi; o[128 + lane] = lo; o[192 + lane] = 0; }
  }
}
__device__ __forceinline__ void k_hy_w4prep(int wv, const float* __restrict__ w4, bf16_t* __restrict__ W4s) {
  int tid_ = otid(wv);
  for (int e = blockIdx.x * 512 + tid_; e < 8192 * 64; e += gridDim.x * 512) { const int col = e & 8191, m = e >> 13;
    const float w = w4[(size_t)m * 8192 + col]; const bf16_t hi = f2bf(w); const bf16_t lo = f2bf(w - __uint_as_float(((unsigned)hi) << 16));
    bf16_t* o = W4s + (size_t)col * 256; o[m] = hi; o[64 + m] = lo; o[128 + m] = hi; o[192 + m] = 0; }
}
__device__ __forceinline__ void k_hy_fnorm(int wv, const float* raw, float* fnorm) {
  int tid_ = otid(wv);
  for (int idx = blockIdx.x * blockDim.x + tid_; idx < 2 * 2 * D; idx += gridDim.x * blockDim.x) {
  const int c = idx % D, o = (idx / D) % 2, ns = idx / (2 * D);
  const int n = ns ? CTXL : SEQ, toff = ns ? SEQ : 0;
  float s = 0.f;
  for (int t = 0; t < n; ++t) s += fabsf(raw[(size_t)(toff + t) * 8192 + o * 4096 + c]);
  for (int t = 1; t < n; ++t) s += fabsf(raw[(size_t)(toff + t) * 8192 + o * 4096 + 2048 + c]);
  fnorm[idx] = s;
  }
}
__device__ __forceinline__ void k_hy_dwconv(int wv, const float* u, const float* cw, const float* cb, float* uc) {
  int tid_ = otid(wv);
  const size_t n = (size_t)MT * 3 * D;
  for (size_t i = (size_t)blockIdx.x * blockDim.x + tid_; i < n; i += (size_t)gridDim.x * blockDim.x) {
    const int row = (int)(i / (3 * D)), col = (int)(i % (3 * D));
    int t, len;
    if (row < ML) { t = row % SEQ; len = SEQ; } else { t = (row - ML) % CTXL; len = CTXL; }
    float a = cb[col];
#pragma unroll
    for (int k = 0; k < 3; ++k) { const int tt = t + k - 1; if (tt >= 0 && tt < len) a += u[(size_t)(row + k - 1) * 3 * D + col] * cw[k * 3 * D + col]; }
    uc[i] = a;
  }
}
__device__ __forceinline__ void k_hy_conv(int wv, const float* zin, int ldz, const float* xk, int ldx, const float* raw, const float* fnorm, const float* bias, int o, float* zout, int ldo) {
  int tid_ = otid(wv);
  const size_t n = (size_t)MT * D;
  for (size_t i = (size_t)blockIdx.x * blockDim.x + tid_; i < n; i += (size_t)gridDim.x * blockDim.x) {
    const int row = (int)(i / D), c = (int)(i % D);
    int t, len, base, toff, ns;
    if (row < ML) { t = row % SEQ; len = SEQ; base = row - t; toff = 0; ns = 0; } else { t = (row - ML) % CTXL; len = CTXL; base = row - t; toff = SEQ; ns = 1; }
    const float* f0 = raw + (size_t)toff * 8192 + o * 4096 + c;
    const float* f1 = f0 + 2048;
    float a = 0.f;
    for (int s = 0; s <= t; ++s) a += zin[(size_t)(base + s) * ldz + c] * f0[(size_t)(t - s) * 8192];
    for (int s = t + 1; s < len; ++s) a += zin[(size_t)(base + s) * ldz + c] * f1[(size_t)(s - t) * 8192];
    const float y = a / fnorm[(ns * 2 + o) * D + c] + zin[(size_t)row * ldz + c] * bias[o * D + c];
    zout[(size_t)row * ldo + c] = xk[(size_t)row * ldx + c] * y;
  }
}


#define FD __device__ __forceinline__
#define HWSIN(f) __builtin_amdgcn_sinf(f)
#define HWCOS(f) __builtin_amdgcn_cosf(f)
typedef float c2 __attribute__((ext_vector_type(2)));
FD c2 cmul(c2 a, c2 b) { const c2 t = {-b.y, b.x}; return a.xx * b + a.yy * t; }
FD int pidx(int i) { return i + (i >> 4); }
template <bool INV> FD void dft4(c2& a, c2& b, c2& c, c2& d) {
  const c2 s0 = a + c, s1 = a - c, s2 = b + d, s3 = b - d;
  a = s0 + s2;
  c = s0 - s2;
  const c2 r = {s3.y, -s3.x};
  const c2 m = s1 + r, p = s1 - r;
  if (INV) { b = p; d = m; } else { b = m; d = p; }
}
template <bool INV> FD void dft16(c2 (&v)[16]) {
  c2 w[16];
#pragma unroll
  for (int j = 0; j < 4; ++j) {
    c2 a = v[j], b = v[j + 4], c = v[j + 8], d = v[j + 12];
    dft4<INV>(a, b, c, d);
    w[4 * j + 0] = a; w[4 * j + 1] = b; w[4 * j + 2] = c; w[4 * j + 3] = d;
  }
  const float C1 = 0.92387953251128674f, S1 = 0.38268343236508977f, C2 = 0.70710678118654752f;
#pragma unroll
  for (int j = 0; j < 4; ++j) {
    c2 x[4];
#pragma unroll
    for (int r = 0; r < 4; ++r) {
      const int m = (r * j) & 15;
      float cr, sr;
      switch (m) { case 0: cr = 1.f; sr = 0.f; break; case 1: cr = C1; sr = S1; break; case 2: cr = C2; sr = C2; break; case 3: cr = S1; sr = C1; break;
                   case 4: cr = 0.f; sr = 1.f; break; case 6: cr = -C2; sr = C2; break; default:   cr = -C1; sr = -S1; break; }
      const c2 tw = {cr, INV ? sr : -sr};
      x[r] = (m == 0) ? w[j + 4 * r] : cmul(w[j + 4 * r], tw);
    }
    dft4<INV>(x[0], x[1], x[2], x[3]);
    v[j] = x[0]; v[j + 4] = x[1]; v[j + 8] = x[2]; v[j + 12] = x[3];
  }
}
template <int N, bool INV, bool ZP = false> FD void r16_load(const c2* buf, int t, int Ns, c2 (&v)[16]) {
#pragma unroll
  for (int r = 0; r < 16; ++r) { if (ZP && r >= 8 && Ns == 1) v[r] = {0.f, 0.f}; else v[r] = buf[pidx(t + r * (N / 16))]; }
  if (Ns > 1) {
    const int k = t & (Ns - 1);
    const float base = (float)k * (1.0f / (float)(Ns * 16));
    const c2 tw1 = {HWCOS(base), INV ? HWSIN(base) : -HWSIN(base)};
    c2 tw = tw1;
#pragma unroll
    for (int r = 1; r < 16; ++r) { v[r] = cmul(v[r], tw); tw = cmul(tw, tw1); }
  }
  dft16<INV>(v);
}
template <int N> FD void r16_store(c2* buf, int t, int Ns, const c2 (&v)[16]) {
  const int k = t & (Ns - 1), j0 = (t - k) * 16 + k;
#pragma unroll
  for (int r = 0; r < 16; ++r) buf[pidx(j0 + r * Ns)] = v[r];
}
template <int N, bool INV, bool HALF = false> FD void r2_last(c2* buf, int t) {
#pragma unroll
  for (int m = 0; m < 8; ++m) {
    const int j = t + m * (N / 16);
    const float f = (float)j * (1.0f / (float)N);
    const c2 tw = {HWCOS(f), INV ? HWSIN(f) : -HWSIN(f)};
    const c2 a = buf[pidx(j)], b = cmul(buf[pidx(j + N / 2)], tw);
    buf[pidx(j)] = {a.x + b.x, a.y + b.y}; if (!HALF) buf[pidx(j + N / 2)] = {a.x - b.x, a.y - b.y};
  }
}

#undef FD
typedef __attribute__((address_space(3))) c2 lc2;
template <int N, bool INV, int MODE = 0> __device__ __forceinline__ void fft_lds(c2* buf, int tid) {
  constexpr int T = N / 16;
  asm volatile("" : "+v"(tid));
#pragma unroll
  for (int Ns = 1; Ns * 16 <= N / 2; Ns *= 16) {
    c2 v[16];
    if (tid < T) r16_load<N, INV, MODE == 1>(buf, tid, Ns, v);
    LDS_BARRIER();
    if (tid < T) r16_store<N>(buf, tid, Ns, v);
    LDS_BARRIER();
  }
  if (tid < T) r2_last<N, INV, MODE == 2>(buf, tid);
  LDS_BARRIER();
}
constexpr int HY_RAW_LD = SEQ + CTXL;
template <int N> __device__ __forceinline__ void hy_conv_chan(int tid_in, int c, const float* __restrict__ uT, const float* __restrict__ rawT, const float* __restrict__ conv_w,
                                                              const float* __restrict__ conv_b, const float* __restrict__ hy_bias, float* __restrict__ zT, c2* sig, c2* fil, float* red) {
  constexpr int n = N / 2, tt0 = (N == 2 * SEQ) ? 0 : SEQ, tok0 = (N == 2 * SEQ) ? 0 : ML, EPT = (n + 511) / 512;
  int tid = tid_in;
#define OPQ_TID() asm volatile("" : "+v"(tid))
  OPQ_TID();
  const float* r00 = rawT + (size_t)(0 * 4096 + 0 * 2048 + c) * HY_RAW_LD + tt0;
  const float* r01 = rawT + (size_t)(0 * 4096 + 1 * 2048 + c) * HY_RAW_LD + tt0;
  const float* r10 = rawT + (size_t)(1 * 4096 + 0 * 2048 + c) * HY_RAW_LD + tt0;
  const float* r11 = rawT + (size_t)(1 * 4096 + 1 * 2048 + c) * HY_RAW_LD + tt0;
  float a0 = 0.f, a1 = 0.f;
  if constexpr (n >= 512) {
    constexpr int NH = n / 512;
    float f0[NH], f1[NH], g0[NH], g1[NH];
    const float* q01 = r01 + n - tid; const float* q11 = r11 + n - tid;
#pragma unroll
    for (int m = 0; m < NH; ++m) { f0[m] = r00[tid + 512 * m]; f1[m] = r10[tid + 512 * m]; }
#pragma unroll
    for (int m = 0; m < NH; ++m) { g0[m] = q01[-512 * m]; g1[m] = q11[-512 * m]; }
#pragma unroll
    for (int m = 0; m < NH; ++m) { const int l = tid + 512 * m; fil[pidx(l)] = {f0[m], f1[m]}; a0 += fabsf(f0[m]); a1 += fabsf(f1[m]);
      const bool z = (m == 0) && (tid == 0); const float x0 = z ? 0.f : g0[m], x1 = z ? 0.f : g1[m];
      fil[pidx(n + l)] = {x0, x1}; a0 += fabsf(x0); a1 += fabsf(x1); }
  } else {
    const int l = tid;
    float k0, k1;
    if (l < n) { k0 = r00[l]; k1 = r10[l]; } else if (l == n) { k0 = 0.f; k1 = 0.f; } else { k0 = r01[N - l]; k1 = r11[N - l]; }
    fil[pidx(l)] = {k0, k1}; a0 += fabsf(k0); a1 += fabsf(k1);
  }
  a0 = block_sum(a0, red, tid); a1 = block_sum(a1, red, tid);
  const float inv0 = 1.0f / (a0 * (float)N), inv1 = 1.0f / (a1 * (float)N);
  LDS_BARRIER();
  const float b0 = hy_bias[c], b1 = hy_bias[D + c];
  struct Raw { float l0[EPT], m0[EPT], r0[EPT], l1[EPT], m1[EPT], r1[EPT]; };
  auto load_raw = [&](int ch, Raw& R) {
    const float* p0 = uT + (size_t)ch * MT + tok0 + tid; const float* p1 = p0 + n;
#pragma unroll
    for (int m = 0; m < EPT; ++m) { R.l0[m] = p0[512 * m - 1]; R.m0[m] = p0[512 * m]; R.r0[m] = p0[512 * m + 1]; R.l1[m] = p1[512 * m - 1]; R.m1[m] = p1[512 * m]; R.r1[m] = p1[512 * m + 1]; }
  };
  auto conv_raw = [&](int ch, const Raw& R, c2 (&out)[EPT]) {
    const float w0 = conv_w[ch], w1 = conv_w[1 * 3 * D + ch], w2 = conv_w[2 * 3 * D + ch], cb = conv_b[ch];
#pragma unroll
    for (int m = 0; m < EPT; ++m) { const int t = tid + 512 * m; const bool hl = t > 0, hr = t < n - 1;
      out[m] = {cb + R.m0[m] * w1 + (hl ? R.l0[m] : 0.f) * w0 + (hr ? R.r0[m] : 0.f) * w2, cb + R.m1[m] * w1 + (hl ? R.l1[m] : 0.f) * w0 + (hr ? R.r1[m] : 0.f) * w2}; }
  };
  typedef __fp16 h2 __attribute__((ext_vector_type(2)));
  h2 vch[EPT], z1h[EPT];
  {
    Raw rv; load_raw(c, rv);
    fft_lds<N, false>(fil, tid);
    OPQ_TID();
    c2 vc[EPT]; conv_raw(c, rv, vc);
#pragma unroll
    for (int m = 0; m < EPT; ++m) { const int t = tid + 512 * m; vch[m] = __builtin_amdgcn_cvt_pkrtz(vc[m].x, vc[m].y); if (t < n) { sig[pidx(t)] = vc[m]; } }
  }
  {
    Raw rx; load_raw(D + c, rx);
    LDS_BARRIER();
    fft_lds<N, false, 1>(sig, tid);
    OPQ_TID();
    for (int f = tid; f < N; f += 512) { const c2 Z = fil[pidx(f)], Zc = fil[pidx((N - f) & (N - 1))];
      const c2 K0 = {0.5f * (Z.x + Zc.x) * inv0, 0.5f * (Z.y - Zc.y) * inv0}; sig[pidx(f)] = cmul(sig[pidx(f)], K0); }
    LDS_BARRIER();
    fft_lds<N, true, 2>(sig, tid);
    OPQ_TID();
    c2 x1[EPT]; conv_raw(D + c, rx, x1);
    c2 z1[EPT];
#pragma unroll
    for (int m = 0; m < EPT; ++m) { const int t = tid + 512 * m; const c2 y = sig[pidx(t < n ? t : 0)]; z1[m] = {x1[m].x * (y.x + (float)vch[m][0] * b0), x1[m].y * (y.y + (float)vch[m][1] * b0)}; z1h[m] = __builtin_amdgcn_cvt_pkrtz(z1[m].x, z1[m].y); }
    LDS_BARRIER();
#pragma unroll
    for (int m = 0; m < EPT; ++m) { const int t = tid + 512 * m; if (t < n) { sig[pidx(t)] = z1[m]; } }
  }
  {
    Raw rx; load_raw(2 * D + c, rx);
    LDS_BARRIER();
    fft_lds<N, false, 1>(sig, tid);
    OPQ_TID();
    for (int f = tid; f < N; f += 512) { const c2 Z = fil[pidx(f)], Zc = fil[pidx((N - f) & (N - 1))];
      const c2 K1 = {0.5f * (Z.y + Zc.y) * inv1, -0.5f * (Z.x - Zc.x) * inv1}; sig[pidx(f)] = cmul(sig[pidx(f)], K1); }
    LDS_BARRIER();
    fft_lds<N, true, 2>(sig, tid);
    OPQ_TID();
    c2 x2[EPT]; conv_raw(2 * D + c, rx, x2);
    float* za = zT + (size_t)c * MT + tok0; float* zb = za + n;
#pragma unroll
    for (int m = 0; m < EPT; ++m) { const int t = tid + 512 * m;
      if (t < n) { const c2 y = sig[pidx(t)]; za[t] = x2[m].x * (y.x + (float)z1h[m][0] * b1); zb[t] = x2[m].y * (y.y + (float)z1h[m][1] * b1); } }
  }
  LDS_BARRIER();
#undef OPQ_TID
}
constexpr int FFT_BUF_BYTES = (2 * SEQ + 2 * SEQ / 16) * 8;
__device__ __forceinline__ void hy_ctx_direct(int wv, int lane, int c, const float* __restrict__ uT, const float* __restrict__ rawT, const float* __restrict__ conv_w,
                                              const float* __restrict__ conv_b, const float* __restrict__ hy_bias, float* __restrict__ zT) {
  constexpr int n = CTXL;
  float* F = (float*)(dyn_lds() + wv * 8192); c2* Z = (c2*)(F + 1024);
  float fv[2][8]; float nrm0 = 0.f, nrm1 = 0.f;
#pragma unroll
  for (int o = 0; o < 2; ++o) { const float* rf = rawT + (size_t)(o * 4096 + c) * HY_RAW_LD + SEQ; const float* rb = rawT + (size_t)(o * 4096 + 2048 + c) * HY_RAW_LD + SEQ;
#pragma unroll
    for (int k = 0; k < 8; ++k) { const int L = lane + 64 * k, lag = L - 256; const int idx = lag >= 0 ? lag : -lag; const float x = (lag >= 0 ? rf : rb)[idx]; fv[o][k] = (L == 0) ? 0.f : x; } }
#pragma unroll
  for (int k = 0; k < 8; ++k) { nrm0 += fabsf(fv[0][k]); nrm1 += fabsf(fv[1][k]); }
  nrm0 = wave_sum(nrm0); nrm1 = wave_sum(nrm1);
  const float in0 = 1.0f / nrm0, in1 = 1.0f / nrm1;
#pragma unroll
  for (int k = 0; k < 8; ++k) { F[lane + 64 * k] = fv[0][k] * in0; F[512 + lane + 64 * k] = fv[1][k] * in1; }
  c2 vc[4], x1c[4], x2c[4];
#pragma unroll
  for (int part = 0; part < 3; ++part) { const int ch = part * D + c; const float* p0 = uT + (size_t)ch * MT + ML + lane; const float* p1 = p0 + n;
    const float w0 = conv_w[ch], w1 = conv_w[3 * D + ch], w2 = conv_w[2 * 3 * D + ch], cb = conv_b[ch];
#pragma unroll
    for (int k = 0; k < 4; ++k) { const int t = lane + 64 * k; const bool hl = t > 0, hr = t < n - 1;
      const float l0 = p0[64 * k - 1], m0 = p0[64 * k], r0 = p0[64 * k + 1], l1 = p1[64 * k - 1], m1 = p1[64 * k], r1 = p1[64 * k + 1];
      const c2 o = {cb + m0 * w1 + (hl ? l0 : 0.f) * w0 + (hr ? r0 : 0.f) * w2, cb + m1 * w1 + (hl ? l1 : 0.f) * w0 + (hr ? r1 : 0.f) * w2};
      if (part == 0) vc[k] = o; else if (part == 1) x1c[k] = o; else x2c[k] = o; } }
  const float b0 = hy_bias[c], b1 = hy_bias[D + c];
#pragma unroll
  for (int k = 0; k < 4; ++k) Z[lane + 64 * k] = vc[k];
  c2 z1[4];
#pragma unroll
  for (int o = 0; o < 2; ++o) {
    asm volatile("s_waitcnt lgkmcnt(0)" ::: "memory");
    c2 acc[4] = {{0.f, 0.f}, {0.f, 0.f}, {0.f, 0.f}, {0.f, 0.f}};
    const float* Fo = F + o * 512 + 256 + lane;
    for (int s2 = 0; s2 < n; ++s2) { const c2 z = Z[s2];
#pragma unroll
      for (int k = 0; k < 4; ++k) { const float f = Fo[64 * k - s2]; acc[k].x += z.x * f; acc[k].y += z.y * f; } }
    if (o == 0) {
#pragma unroll
      for (int k = 0; k < 4; ++k) z1[k] = {x1c[k].x * (acc[k].x + vc[k].x * b0), x1c[k].y * (acc[k].y + vc[k].y * b0)};
      asm volatile("s_waitcnt lgkmcnt(0)" ::: "memory");
#pragma unroll
      for (int k = 0; k < 4; ++k) Z[lane + 64 * k] = z1[k];
    } else {
      float* za = zT + (size_t)c * MT + ML; float* zb = za + n;
#pragma unroll
      for (int k = 0; k < 4; ++k) { const int t = lane + 64 * k; za[t] = x2c[k].x * (acc[k].x + z1[k].x * b1); zb[t] = x2c[k].y * (acc[k].y + z1[k].y * b1); }
    }
  }
}
__device__ __forceinline__ void k_hy_fftconv(int wv, const float* uT, const float* rawT, const float* conv_w, const float* conv_b, const float* hy_bias, float* zT) {
  int tid_ = otid(wv);
  c2* sig = (c2*)dyn_lds(); c2* fil = (c2*)(dyn_lds() + FFT_BUF_BYTES); float* red = (float*)(dyn_lds() + 2 * FFT_BUF_BYTES);
  __syncthreads();
  for (int c = blockIdx.x; c < D; c += gridDim.x) hy_conv_chan<2 * SEQ>(tid_, c, uT, rawT, conv_w, conv_b, hy_bias, zT, sig, fil, red);
  __syncthreads();
  { const int lane = tid_ & 63; for (int c = wv * gridDim.x + blockIdx.x; c < D; c += gridDim.x * 8) hy_ctx_direct(wv, lane, c, uT, rawT, conv_w, conv_b, hy_bias, zT); }
  __syncthreads();
}
constexpr int S5_ROWS = 2 * 272, S5_T = 16;
constexpr size_t S5_SLAB = (size_t)S5_ROWS * 512 + 128;
__device__ __forceinline__ int s5_token_row(int b, int pos, int col_major) {
  if (pos < CTXL) return ML + b * CTXL + pos;
  const int q = pos - CTXL;
  return b * SEQ + (col_major ? ((q & 63) * 64 + (q >> 6)) : q);
}
struct S5W { const float *a_re, *a_im, *log_dt, *b_re, *b_im, *c_re, *c_im, *dvec; bf16_t *Pt, *TQt; };
__device__ __forceinline__ void k_s5_ops(int wv, const S5W w0, const S5W w1) {
  int tid_ = otid(wv);
  c2* lamp = (c2*)dyn_lds(); c2* Bb = lamp + 2 * 64 * 17; c2* Cc = Bb + 2 * 64 * 16; float* Kc = (float*)(Cc + 2 * 16 * 65);
  for (int item = blockIdx.x; item < 2 * G; item += gridDim.x) {
    const int g = item & (G - 1); const S5W& W = (item >> 7) ? w1 : w0;
    const float* a_re = W.a_re; const float* a_im = W.a_im; const float* log_dt = W.log_dt;
    __syncthreads();
    for (int e = tid_; e < 2 * 64 * 17; e += 512) { const int m = e % 17, p = (e / 17) % 64, d = e / (17 * 64);
      const int gp = (d * G + g) * P + p; const float dt = expf(log_dt[d * G + g]);
      const float mag = expf((float)m * a_re[gp] * dt); float sn, cs; sincosf((float)m * a_im[gp] * dt, &sn, &cs);
      lamp[e] = {mag * cs, mag * sn}; }
    for (int e = tid_; e < 2 * 64 * 16; e += 512) { const int j = e % 16, p = (e / 16) % 64, d = e / (16 * 64);
      const int gp = (d * G + g) * P + p; const float are = a_re[gp], aim = a_im[gp], dt = expf(log_dt[d * G + g]);
      const float mag = expf(are * dt); float sn, cs; sincosf(aim * dt, &sn, &cs);
      const float nr = mag * cs - 1.0f, ni = mag * sn, den = are * are + aim * aim;
      const c2 q = {(nr * are + ni * aim) / den, (ni * are - nr * aim) / den};
      const c2 bb = {W.b_re[(size_t)gp * 16 + j], W.b_im[(size_t)gp * 16 + j]};
      Bb[e] = cmul(q, bb); }
    for (int e = tid_; e < 2 * 16 * 64; e += 512) { const int p = e & 63, i = (e >> 6) & 15, d = e >> 10; const size_t src = ((size_t)(d * G + g) * 16 + i) * P + p; Cc[(d * 16 + i) * 65 + p] = {W.c_re[src], W.c_im[src]}; }
    __syncthreads();
    {
      const int i = tid_ & 15, l = (tid_ >> 4) & 15, d = tid_ >> 8;
      float acc[16];
#pragma unroll
      for (int j = 0; j < 16; ++j) acc[j] = 0.f;
#pragma unroll 2
      for (int p = 0; p < 64; ++p) { const c2 t1 = cmul(Cc[(d * 16 + i) * 65 + p], lamp[(d * 64 + p) * 17 + l]); const c2* bp = Bb + (d * 64 + p) * 16;
#pragma unroll
        for (int j = 0; j < 16; ++j) { const c2 bb = bp[j]; acc[j] += t1.x * bb.x - t1.y * bb.y; } }
#pragma unroll
      for (int j4 = 0; j4 < 4; ++j4) *(f32x4*)(Kc + tid_ * 16 + j4 * 4) = (f32x4){acc[j4 * 4], acc[j4 * 4 + 1], acc[j4 * 4 + 2], acc[j4 * 4 + 3]}; }
    __syncthreads();
    bf16_t* Pg = W.Pt + (size_t)g * 256 * 256;
    for (int c = tid_; c < 2 * 64 * 16; c += 512) { const int s = c & 15, p = (c >> 4) & 63, d = c >> 10;
      const int ex = d == 0 ? 15 - s : s;
      const c2 lam = lamp[(d * 64 + p) * 17 + ex]; const c2* bp = Bb + (d * 64 + p) * 16;
      unsigned re[8], im[8];
#pragma unroll
      for (int j2 = 0; j2 < 8; ++j2) { const c2 v0 = cmul(lam, bp[2 * j2]), v1 = cmul(lam, bp[2 * j2 + 1]); re[j2] = pg8::cvt_pk_bf16(v0.x, v1.x); im[j2] = pg8::cvt_pk_bf16(v0.y, v1.y); }
      bf16_t* o = Pg + (size_t)(d * 128 + p) * 256 + s * 16;
      *(pg8::u32x4*)o = (pg8::u32x4){re[0], re[1], re[2], re[3]}; *(pg8::u32x4*)(o + 8) = (pg8::u32x4){re[4], re[5], re[6], re[7]};
      *(pg8::u32x4*)(o + 64 * 256) = (pg8::u32x4){im[0], im[1], im[2], im[3]}; *(pg8::u32x4*)(o + 64 * 256 + 8) = (pg8::u32x4){im[4], im[5], im[6], im[7]}; }
    bf16_t* Tg = W.TQt + (size_t)g * 256 * 512;
    for (int c = tid_; c < 16 * 16 * 16; c += 512) { const int sx = c & 15, i = (c >> 4) & 15, t = c >> 8;
      float v[16];
#pragma unroll
      for (int j = 0; j < 16; ++j) v[j] = 0.f;
      if (t >= sx) { const float* k0 = Kc + ((0 * 16 + (t - sx)) * 16 + i) * 16;
#pragma unroll
        for (int j4 = 0; j4 < 4; ++j4) { const f32x4 q = *(const f32x4*)(k0 + 4 * j4); v[4 * j4] += q[0]; v[4 * j4 + 1] += q[1]; v[4 * j4 + 2] += q[2]; v[4 * j4 + 3] += q[3]; } }
      if (sx >= t) { const float* k1 = Kc + ((1 * 16 + (sx - t)) * 16 + i) * 16;
#pragma unroll
        for (int j4 = 0; j4 < 4; ++j4) { const f32x4 q = *(const f32x4*)(k1 + 4 * j4); v[4 * j4] += q[0]; v[4 * j4 + 1] += q[1]; v[4 * j4 + 2] += q[2]; v[4 * j4 + 3] += q[3]; } }
      const float dv = (sx == t) ? W.dvec[g * 16 + i] : 0.f;
#pragma unroll
      for (int j = 0; j < 16; ++j) v[j] += (j == i) ? dv : 0.f;
      bf16_t* o = Tg + (size_t)(t * 16 + i) * 512 + sx * 16;
      *(pg8::u32x4*)o = (pg8::u32x4){pg8::cvt_pk_bf16(v[0], v[1]), pg8::cvt_pk_bf16(v[2], v[3]), pg8::cvt_pk_bf16(v[4], v[5]), pg8::cvt_pk_bf16(v[6], v[7])};
      *(pg8::u32x4*)(o + 8) = (pg8::u32x4){pg8::cvt_pk_bf16(v[8], v[9]), pg8::cvt_pk_bf16(v[10], v[11]), pg8::cvt_pk_bf16(v[12], v[13]), pg8::cvt_pk_bf16(v[14], v[15])}; }
    for (int c = tid_; c < 16 * 16 * 2 * 8; c += 512) { const int pgp = c & 7, d = (c >> 3) & 1, i = (c >> 4) & 15, t = c >> 8;
      const int m = d == 0 ? t + 1 : 16 - t;
      unsigned re[4], im[4];
#pragma unroll
      for (int u = 0; u < 4; ++u) { const int p0 = pgp * 8 + 2 * u;
        const c2 q0 = cmul(Cc[(d * 16 + i) * 65 + p0], lamp[(d * 64 + p0) * 17 + m]), q1 = cmul(Cc[(d * 16 + i) * 65 + p0 + 1], lamp[(d * 64 + p0 + 1) * 17 + m]);
        re[u] = pg8::cvt_pk_bf16(q0.x, q1.x); im[u] = pg8::cvt_pk_bf16(-q0.y, -q1.y); }
      bf16_t* o = Tg + (size_t)(t * 16 + i) * 512 + 256 + d * 128 + pgp * 8;
      *(pg8::u32x4*)o = (pg8::u32x4){re[0], re[1], re[2], re[3]}; *(pg8::u32x4*)(o + 64) = (pg8::u32x4){im[0], im[1], im[2], im[3]}; }
  }
}
template <int NS> __device__ __forceinline__ void k_s5_modnorm(int wv, float* xb, const float* xctx_in, const float* __restrict__ gnorm, const float* __restrict__ modl, bf16_t* __restrict__ UH, int col_major, Pend pd) {
  const int lane = lane_opq();
  const int nwave = gridDim.x * 8, wave = wv * gridDim.x + blockIdx.x;
  for (int row = wave; row < MT; row += nwave) {
    const int r = stream_of(row);
    int b, pos;
    if (row < ML) { b = row / SEQ; const int t = row % SEQ; pos = CTXL + (col_major ? ((t & 63) * 64 + (t >> 6)) : t); } else { b = (row - ML) / CTXL; pos = (row - ML) % CTXL; }
    const int cc = b * 272 + (pos >> 4), s = pos & 15;
    float* x = (row >= ML && xctx_in != nullptr ? (float*)xctx_in + (size_t)(row - ML) * D : xb + (size_t)row * D) + lane * 4;
    const float* sh = modl + (size_t)r * NMOD + 0 * D + lane * 4; const float* sc = modl + (size_t)r * NMOD + 1 * D + lane * 4; const float* gn = gnorm + lane * 4;
    f32x4 xv[8], gv[8], scv[8], shv[8];
#pragma unroll
    for (int q = 0; q < 8; ++q) { xv[q] = *(const f32x4*)(x + 256 * q); gv[q] = *(const f32x4*)(gn + 256 * q); scv[q] = *(const f32x4*)(sc + 256 * q); shv[q] = *(const f32x4*)(sh + 256 * q); }
    if (NS > 0 && row >= ML) {
#pragma unroll
      for (int q = 0; q < 8; ++q) { f32x4 pv[NS > 0 ? NS : 1];
#pragma unroll
        for (int sl = 0; sl < NS; ++sl) pv[sl] = *(const f32x4*)(pd.P + ((size_t)sl * MC + (row - ML)) * D + lane * 4 + 256 * q);
        f32x4 a = {0.f, 0.f, 0.f, 0.f}; if (pd.bias) a = *(const f32x4*)(pd.bias + lane * 4 + 256 * q);
#pragma unroll
        for (int sl = 0; sl < NS; ++sl) a += pv[sl];
        xv[q] += *(const f32x4*)(pd.gate + lane * 4 + 256 * q) * a; *(f32x4*)(x + 256 * q) = xv[q]; }
    }
    float ss = 0.f;
#pragma unroll
    for (int q = 0; q < 8; ++q) ss += xv[q][0] * xv[q][0] + xv[q][1] * xv[q][1] + xv[q][2] * xv[q][2] + xv[q][3] * xv[q][3];
    ss = wave_sum(ss);
    const float rstd = rsqrtf(ss / D + 1e-6f);
#pragma unroll
    for (int q = 0; q < 8; ++q) { f32x4 h;
#pragma unroll
      for (int jj = 0; jj < 4; ++jj) h[jj] = xv[q][jj] * rstd * gv[q][jj] * (1.0f + scv[q][jj]) + shv[q][jj];
      *(u32x2*)(UH + (size_t)(16 * q + (lane >> 2)) * S5_SLAB + (size_t)cc * 512 + s * 16 + 4 * (lane & 3)) = (u32x2){pg8::cvt_pk_bf16(h[0], h[1]), pg8::cvt_pk_bf16(h[2], h[3])}; }
  }
}
__device__ __forceinline__ c2 cfma(c2 a, c2 b, c2 c) { c2 r; r.x = a.x * b.x - a.y * b.y + c.x; r.y = a.x * b.y + a.y * b.x + c.y; return r; }
__device__ __forceinline__ void k_s5_scanmm(int wv, const float* a_re, const float* a_im, const float* log_dt, const bf16_t* __restrict__ Pt, bf16_t* __restrict__ UH) {
  const int lane = lane_opq(), fr = lane & 15, fq = lane >> 4, tid_ = wv * 64 + lane;
  const int dir = wv >> 2, wq = wv & 3, p = wq * 16 + fr;
  bf16_t* AB = (bf16_t*)dyn_lds();
  constexpr int TS = 16 * 264;
  for (int item = blockIdx.x; item < 2 * G; item += gridDim.x) {
    const int gsel = ((item >> 5) << 3) | (item & 7), g = (gsel & 31) * 4 + ((item >> 3) & 3), b = gsel >> 5;
    const int gp = (dir * G + g) * P + p; const float dt = expf(log_dt[dir * G + g]);
    c2 L1; { const float mag = expf(16.0f * a_re[gp] * dt); float sn, cs; sincosf(16.0f * a_im[gp] * dt, &sn, &cs); L1 = {mag * cs, mag * sn}; }
    const c2 L2 = cmul(L1, L1), L4 = cmul(L2, L2);
    bf16x8 bre[8], bim[8];
    const bf16_t* Pg = Pt + (size_t)g * 256 * 256;
#pragma unroll
    for (int ks = 0; ks < 8; ++ks) { bre[ks] = *(const bf16x8*)(Pg + (size_t)(dir * 128 + p) * 256 + ks * 32 + fq * 8); bim[ks] = *(const bf16x8*)(Pg + (size_t)(dir * 128 + 64 + p) * 256 + ks * 32 + fq * 8); }
    c2 Hin = {0.f, 0.f};
    bf16_t* Ug = UH + (size_t)g * S5_SLAB + (size_t)b * 272 * 512;
    const int srow = tid_ >> 5, scol = (tid_ & 31) * 8;
    auto tile_of = [&](int it, int d) { return d == 0 ? it : (it == 0 ? 0 : 17 - it); };
    pg8::u32x4 pre0, pre1;
    pre0 = *(const pg8::u32x4*)(Ug + (size_t)(tile_of(0, 0) * 16 + srow) * 512 + scol); pre1 = *(const pg8::u32x4*)(Ug + (size_t)(tile_of(0, 1) * 16 + srow) * 512 + scol);
    LDS_BARRIER();
    *(pg8::u32x4*)(AB + 0 * TS + srow * 264 + scol) = pre0; *(pg8::u32x4*)(AB + 1 * TS + srow * 264 + scol) = pre1;
    LDS_BARRIER();
    for (int it = 0; it < 17; ++it) {
      const int rt = tile_of(it, dir);
      if (it + 1 < 17) { pre0 = *(const pg8::u32x4*)(Ug + (size_t)(tile_of(it + 1, 0) * 16 + srow) * 512 + scol); pre1 = *(const pg8::u32x4*)(Ug + (size_t)(tile_of(it + 1, 1) * 16 + srow) * 512 + scol); }
      f32x4 are = {0.f, 0.f, 0.f, 0.f}, aim = {0.f, 0.f, 0.f, 0.f};
      const bf16_t* arow = AB + ((it & 1) * 2 + dir) * TS + fr * 264 + fq * 8;
#pragma unroll
      for (int ks = 0; ks < 8; ++ks) { const bf16x8 a = *(const bf16x8*)(arow + ks * 32);
        are = __builtin_amdgcn_mfma_f32_16x16x32_bf16(a, bre[ks], are, 0, 0, 0); aim = __builtin_amdgcn_mfma_f32_16x16x32_bf16(a, bim[ks], aim, 0, 0, 0); }
      c2 v[4];
#pragma unroll
      for (int k = 0; k < 4; ++k) { const int i = dir == 0 ? k : 3 - k; v[k] = {are[i], aim[i]}; }
      c2 e = v[0]; e = cfma(L1, e, v[1]); e = cfma(L1, e, v[2]); e = cfma(L1, e, v[3]);
      const int gq = dir == 0 ? fq : 3 - fq;
      c2 E[4];
#pragma unroll
      for (int k = 0; k < 4; ++k) { const int srcq = dir == 0 ? k : 3 - k; const int src = (srcq * 16 + fr) << 2;
        E[k].x = __int_as_float(__builtin_amdgcn_ds_bpermute(src, __float_as_int(e.x))); E[k].y = __int_as_float(__builtin_amdgcn_ds_bpermute(src, __float_as_int(e.y))); }
      const c2 C1 = cfma(L4, Hin, E[0]), C2 = cfma(L4, C1, E[1]), C3 = cfma(L4, C2, E[2]), Hout = cfma(L4, C3, E[3]);
      c2 hb = gq == 0 ? Hin : (gq == 1 ? C1 : (gq == 2 ? C2 : C3));
#pragma unroll
      for (int k = 0; k < 4; ++k) { const int i = dir == 0 ? k : 3 - k;
        bf16_t* dst = Ug + (size_t)(rt * 16 + fq * 4 + i) * 512 + 256 + dir * 128 + p;
        dst[0] = f2bf(hb.x); dst[64] = f2bf(hb.y);
        hb = cfma(L1, hb, v[k]); }
      Hin = Hout;
      if (it + 1 < 17) { *(pg8::u32x4*)(AB + (((it + 1) & 1) * 2 + 0) * TS + srow * 264 + scol) = pre0; *(pg8::u32x4*)(AB + (((it + 1) & 1) * 2 + 1) * TS + srow * 264 + scol) = pre1; }
      LDS_BARRIER();
    }
  }
}
__device__ __forceinline__ float fgelu_tanh(float x) { const float u = 0.7978845608028654f * (x + 0.044715f * x * x * x); const float t = 1.0f - 2.0f * __builtin_amdgcn_rcpf(1.0f + __expf(2.0f * u)); return 0.5f * x * (1.0f + t); }
__device__ __forceinline__ void k_s5_outmm(int wv, const bf16_t* __restrict__ TQt, const bf16_t* __restrict__ UH, bf16_t* __restrict__ Zb, int col_major) {
  const int lane = lane_opq(), fr = lane & 15, fq = lane >> 4, tid_ = wv * 64 + lane;
  bf16_t* AB = (bf16_t*)dyn_lds();
  constexpr int TS = 16 * 520;
  for (int item = blockIdx.x; item < 2 * G; item += gridDim.x) {
    const int gsel = ((item >> 5) << 3) | (item & 7), g = (gsel & 31) * 4 + ((item >> 3) & 3), b = gsel >> 5;
    const bf16_t* Tg = TQt + (size_t)g * 256 * 512;
    bf16x8 bfr[2][16];
#pragma unroll
    for (int ct = 0; ct < 2; ++ct)
#pragma unroll
      for (int ks = 0; ks < 16; ++ks) bfr[ct][ks] = *(const bf16x8*)(Tg + (size_t)(wv * 32 + ct * 16 + fr) * 512 + ks * 32 + fq * 8);
    const bf16_t* Ug = UH + (size_t)g * S5_SLAB + (size_t)b * 272 * 512;
    const int srow = tid_ >> 6, scol = (tid_ & 63) * 8;
    pg8::u32x4 pre0, pre1;
    pre0 = *(const pg8::u32x4*)(Ug + (size_t)srow * 512 + scol); pre1 = *(const pg8::u32x4*)(Ug + (size_t)(srow + 8) * 512 + scol);
    LDS_BARRIER();
    *(pg8::u32x4*)(AB + srow * 520 + scol) = pre0; *(pg8::u32x4*)(AB + (srow + 8) * 520 + scol) = pre1;
    LDS_BARRIER();
    for (int rt = 0; rt < 17; ++rt) {
      if (rt + 1 < 17) { pre0 = *(const pg8::u32x4*)(Ug + (size_t)((rt + 1) * 16 + srow) * 512 + scol); pre1 = *(const pg8::u32x4*)(Ug + (size_t)((rt + 1) * 16 + srow + 8) * 512 + scol); }
      f32x4 acc0 = {0.f, 0.f, 0.f, 0.f}, acc1 = {0.f, 0.f, 0.f, 0.f};
      const bf16_t* arow = AB + (rt & 1) * TS + fr * 520 + fq * 8;
#pragma unroll
      for (int ks = 0; ks < 16; ++ks) { const bf16x8 a = *(const bf16x8*)(arow + ks * 32);
        acc0 = __builtin_amdgcn_mfma_f32_16x16x32_bf16(a, bfr[0][ks], acc0, 0, 0, 0); acc1 = __builtin_amdgcn_mfma_f32_16x16x32_bf16(a, bfr[1][ks], acc1, 0, 0, 0); }
#pragma unroll
      for (int i = 0; i < 4; ++i) { const int c = rt * 16 + fq * 4 + i;
#pragma unroll
        for (int ct = 0; ct < 2; ++ct) { const int t = wv * 2 + ct; const int row = s5_token_row(b, c * 16 + t, col_major);
          Zb[(size_t)row * D + g * 16 + fr] = f2bf(fgelu_tanh(ct ? acc1[i] : acc0[i])); } }
      if (rt + 1 < 17) { *(pg8::u32x4*)(AB + ((rt + 1) & 1) * TS + srow * 520 + scol) = pre0; *(pg8::u32x4*)(AB + ((rt + 1) & 1) * TS + (srow + 8) * 520 + scol) = pre1; }
      LDS_BARRIER();
    }
  }
}

constexpr int GDN_NCH = 68, GDN_ITEMS = NBATCH * GDN_NCH * 32 * 2;
__device__ __forceinline__ int gdn_row(int b, int ch, int ri) { return ch < 4 ? ML + b * CTXL + ch * 64 + ri : b * SEQ + (ch - 4) * 64 + ri; }
__device__ __forceinline__ int gdn_seq_lo(int row) { return row < ML ? (row & ~(SEQ - 1)) : ML + ((row - ML) & ~(CTXL - 1)); }
__device__ __forceinline__ int gdn_seq_hi(int row) { return row < ML ? (row | (SEQ - 1)) : ML + ((row - ML) | (CTXL - 1)); }
__device__ __forceinline__ void k_gdn_feat(int wv, const bf16_t* __restrict__ proj, const float* __restrict__ gab, const float* __restrict__ cw, const float* __restrict__ a_log, const float* __restrict__ dt_bias,
                                           bf16_t* __restrict__ qn, bf16_t* __restrict__ kn, bf16_t* __restrict__ vv, float* __restrict__ gg, float* __restrict__ bt) {
  const int lane = lane_opq(), tid_ = wv * 64 + lane;
  float* cws = (float*)dyn_lds();
  __syncthreads();
  for (int e = tid_; e < 4 * GDN_CONV / 4; e += 512) ((f32x4*)cws)[e] = ((const f32x4*)cw)[e];
  __syncthreads();
  constexpr int RPB = MT / 256;
  const int chA = tid_ * 8, chB = 4096 + tid_ * 8;
  f32x4 c4[4];
#pragma unroll
  for (int q = 0; q < 4; ++q) c4[q] = *(const f32x4*)(cw + 4 * GDN_CONV + (q < 2 ? chA : chB) + 4 * (q & 1));
  for (int rb = blockIdx.x * RPB; rb < MT; rb += gridDim.x * RPB) {
    for (int r0 = rb; r0 < rb + RPB; r0 += 2) {
      f32x4 x[6][4];
      pg8::u32x4 xr[6][2];
#pragma unroll
      for (int k = 0; k < 6; ++k) { int rr = r0 + k - 2; rr = rr < 0 ? 0 : (rr > MT - 1 ? MT - 1 : rr);
        xr[k][0] = *(const pg8::u32x4*)(proj + (size_t)rr * 12288 + chA); xr[k][1] = *(const pg8::u32x4*)(proj + (size_t)rr * 12288 + chB); }
#pragma unroll
      for (int k = 0; k < 6; ++k)
#pragma unroll
        for (int q = 0; q < 4; ++q) { const unsigned lo = xr[k][q >> 1][(q & 1) * 2], hi = xr[k][q >> 1][(q & 1) * 2 + 1];
          x[k][q] = (f32x4){__uint_as_float(lo << 16), __uint_as_float(lo & 0xFFFF0000u), __uint_as_float(hi << 16), __uint_as_float(hi & 0xFFFF0000u)}; }
#pragma unroll
      for (int ro = 0; ro < 2; ++ro) { const int row = r0 + ro; const int lo = gdn_seq_lo(row), hi = gdn_seq_hi(row);
        f32x4 a[4] = {{0.f, 0.f, 0.f, 0.f}, {0.f, 0.f, 0.f, 0.f}, {0.f, 0.f, 0.f, 0.f}, {0.f, 0.f, 0.f, 0.f}};
#pragma unroll
        for (int k = 0; k < 5; ++k) { const int rr = row + k - 2; const float ok = (rr >= lo && rr <= hi) ? 1.0f : 0.0f;
#pragma unroll
          for (int q = 0; q < 4; ++q) { const f32x4 w = (k < 4) ? *(const f32x4*)(cws + k * GDN_CONV + (q < 2 ? chA : chB) + 4 * (q & 1)) : c4[q]; a[q] += x[ro + k][q] * (w * ok); } }
        float ss = 0.f;
#pragma unroll
        for (int q = 0; q < 4; ++q)
#pragma unroll
          for (int jj = 0; jj < 4; ++jj) { const float v = fsilu(a[q][jj]); a[q][jj] = v; if (q < 2) ss += v * v; }
        ss += __int_as_float(__builtin_amdgcn_ds_bpermute((lane ^ 1) << 2, __float_as_int(ss)));
        ss += __int_as_float(__builtin_amdgcn_ds_bpermute((lane ^ 2) << 2, __float_as_int(ss)));
        ss += __int_as_float(__builtin_amdgcn_ds_bpermute((lane ^ 4) << 2, __float_as_int(ss)));
        ss += __int_as_float(__builtin_amdgcn_ds_bpermute((lane ^ 8) << 2, __float_as_int(ss)));
        const float sc = rsqrtf(ss + 1e-6f);
        bf16_t* dA = chA < 2048 ? qn + (size_t)row * 2048 + chA : kn + (size_t)row * 2048 + chA - 2048;
        *(pg8::u32x4*)dA = (pg8::u32x4){pg8::cvt_pk_bf16(a[0][0] * sc, a[0][1] * sc), pg8::cvt_pk_bf16(a[0][2] * sc, a[0][3] * sc), pg8::cvt_pk_bf16(a[1][0] * sc, a[1][1] * sc), pg8::cvt_pk_bf16(a[1][2] * sc, a[1][3] * sc)};
        *(pg8::u32x4*)(vv + (size_t)row * 4096 + tid_ * 8) = (pg8::u32x4){pg8::cvt_pk_bf16(a[2][0], a[2][1]), pg8::cvt_pk_bf16(a[2][2], a[2][3]), pg8::cvt_pk_bf16(a[3][0], a[3][1]), pg8::cvt_pk_bf16(a[3][2], a[3][3])};
      }
    }
  }
  for (int i = blockIdx.x * 512 + tid_; i < MT * 64; i += gridDim.x * 512) {
    const int row = i >> 6, j = i & 63;
    const float a = gab[(size_t)row * 256 + j], b = gab[(size_t)row * 256 + 64 + j];
    const float xx = a + dt_bias[j];
    const float sp = xx > 20.f ? xx : log1pf(expf(xx));
    gg[i] = -expf(a_log[j]) * sp;
    bt[i] = sigmoid_f(b);
  }
}
constexpr int GA_KN = 0, GA_QN = 17408, GA_KK = 34816, GA_QK = 51456, GA_L = 68096;
__device__ __forceinline__ void k_gdn_prep(int wv, const bf16_t* __restrict__ qn, const bf16_t* __restrict__ kn, const float* __restrict__ gg, const float* __restrict__ bt,
                                           bf16_t* __restrict__ tinv, bf16_t* __restrict__ attn, float* __restrict__ gcbuf) {
  const int lane = lane_opq(), fr = lane & 15, fq = lane >> 4, tid_ = wv * 64 + lane;
  unsigned char* lds = dyn_lds();
  bf16_t* Kn = (bf16_t*)(lds + GA_KN); bf16_t* Qn = (bf16_t*)(lds + GA_QN); float* KK = (float*)(lds + GA_KK); float* QK = (float*)(lds + GA_QK);
  pg8::u32x4 pk[2], pq[2];
  auto fetch = [&](int sit2) { const int hk = sit2 & 15, ch = (sit2 >> 4) % GDN_NCH, b = sit2 / (16 * GDN_NCH);
#pragma unroll
    for (int it = 0; it < 2; ++it) { const int pc = tid_ + it * 512, i = pc >> 4, dp = (pc & 15) * 8; const size_t src = (size_t)gdn_row(b, ch, i) * 2048 + hk * 128 + dp;
      pk[it] = *(const pg8::u32x4*)(kn + src); pq[it] = *(const pg8::u32x4*)(qn + src); } };
  if ((int)blockIdx.x < NBATCH * GDN_NCH * 16) fetch(blockIdx.x);
  for (int sit = blockIdx.x; sit < NBATCH * GDN_NCH * 16; sit += gridDim.x) {
    const int hk = sit & 15, ch = (sit >> 4) % GDN_NCH, b = sit / (16 * GDN_NCH);
    LDS_BARRIER();
#pragma unroll
    for (int it = 0; it < 2; ++it) { const int pc = tid_ + it * 512, i = pc >> 4, dp = (pc & 15) * 8;
      *(pg8::u32x4*)(Kn + i * 136 + dp) = pk[it]; *(pg8::u32x4*)(Qn + i * 136 + dp) = pq[it]; }
    LDS_BARRIER();
    if (sit + (int)gridDim.x < NBATCH * GDN_NCH * 16) fetch(sit + gridDim.x);
#pragma unroll
    for (int tl = 0; tl < 4; ++tl) { const int tt = wv * 4 + tl, mat = tt >> 4, ti = (tt >> 2) & 3, tj = tt & 3;
      const bf16_t* A = (mat ? Qn : Kn) + (ti * 16 + fr) * 136 + fq * 8; const bf16_t* B = Kn + (tj * 16 + fr) * 136 + fq * 8;
      f32x4 acc = {0.f, 0.f, 0.f, 0.f};
#pragma unroll
      for (int ks = 0; ks < 4; ++ks) acc = __builtin_amdgcn_mfma_f32_16x16x32_bf16(*(const bf16x8*)(A + ks * 32), *(const bf16x8*)(B + ks * 32), acc, 0, 0, 0);
      float* O = mat ? QK : KK;
#pragma unroll
      for (int r = 0; r < 4; ++r) O[(ti * 16 + fq * 4 + r) * 65 + tj * 16 + fr] = acc[r]; }
    LDS_BARRIER();
    {
      const int wq = wv & 3, role = wv >> 2;
      const int dir = wq & 1, hv = hk * 2 + (wq >> 1);
      const int item = ((b * GDN_NCH + ch) * 32 + hv) * 2 + dir;
      float* Lw = (float*)(lds + GA_L) + wq * 4096;
      const int rl = dir ? 63 - lane : lane; const int rowl = gdn_row(b, ch, rl);
      float gcv = gg[(size_t)rowl * 64 + dir * 32 + hv]; const float bel = bt[(size_t)rowl * 64 + dir * 32 + hv];
#pragma unroll
      for (int o = 1; o < 64; o <<= 1) { const float up = __int_as_float(__builtin_amdgcn_ds_bpermute(((lane - o) & 63) << 2, __float_as_int(gcv))); if (lane >= o) gcv += up; }
      if (role == 1) {
        gcbuf[(size_t)item * 64 + lane] = gcv;
        for (int i = 0; i < 64; ++i) {
          const float gci = __int_as_float(__builtin_amdgcn_readlane(__float_as_int(gcv), i));
          const int ri = dir ? 63 - i : i;
          const float dec = __expf(i >= lane ? gci - gcv : 0.f);
          attn[(size_t)item * 4096 + i * 64 + lane] = f2bf(i >= lane ? QK[ri * 65 + rl] * 0.08838834764831845f * dec : 0.f);
        }
      } else {
        for (int i = 0; i < 64; ++i) {
          const float gci = __int_as_float(__builtin_amdgcn_readlane(__float_as_int(gcv), i)), bei = __int_as_float(__builtin_amdgcn_readlane(__float_as_int(bel), i));
          const int ri = dir ? 63 - i : i;
          const float dec = __expf(i >= lane ? gci - gcv : 0.f);
          Lw[i * 64 + lane] = i > lane ? bei * KK[ri * 65 + rl] * dec : 0.f;
        }
        asm volatile("s_waitcnt lgkmcnt(0)" ::: "memory");
        float x[64];
#pragma unroll
        for (int i = 0; i < 64; ++i) {
          float a = (i == lane) ? 1.0f : 0.0f;
#pragma unroll
          for (int j4 = 0; j4 < (i + 3) / 4; ++j4) { const f32x4 l4 = *(const f32x4*)(Lw + i * 64 + j4 * 4);
#pragma unroll
            for (int u = 0; u < 4; ++u) if (j4 * 4 + u < i) a -= l4[u] * x[j4 * 4 + u]; }
          x[i] = a;
          tinv[(size_t)item * 4096 + i * 64 + lane] = f2bf(a);
        }
      }
    }
  }
}
constexpr int GB_KBG = 0, GB_QG = 17408, GB_KGT = 34816, GB_TI = 53248, GB_AT = 62464, GB_VB = 71680, GB_RT = 89088, GB_VNT = 98304, GB_STB = 107520;
__device__ __forceinline__ void k_gdn_chain(int wv, const bf16_t* __restrict__ qn, const bf16_t* __restrict__ kn, const bf16_t* __restrict__ vv, const float* __restrict__ bt,
                                            const bf16_t* __restrict__ tinv, const bf16_t* __restrict__ attn, const float* __restrict__ gcbuf, bf16_t* __restrict__ odir) {
  const int lane = lane_opq(), fr = lane & 15, fq = lane >> 4, tid_ = wv * 64 + lane;
  unsigned char* lds = dyn_lds();
  bf16_t* KR = (bf16_t*)(lds + GB_KBG); bf16_t* QR = (bf16_t*)(lds + GB_QG); bf16_t* VNS = (bf16_t*)(lds + GB_KGT); bf16_t* VR = (bf16_t*)(lds + GB_KGT + 9216); bf16_t* TI = (bf16_t*)(lds + GB_TI); bf16_t* AT = (bf16_t*)(lds + GB_AT);
  float* EG = (float*)(lds + GB_VB); float* BE = EG + 64; float* EGL = EG + 128; bf16_t* RT = (bf16_t*)(lds + GB_RT); bf16_t* VNT = (bf16_t*)(lds + GB_VNT); bf16_t* STB = (bf16_t*)(lds + GB_STB);
  bf16x8 sel;
  { unsigned sw[4];
#pragma unroll
    for (int u = 0; u < 4; ++u) { const int k0 = fq * 8 + 2 * u, tgt = (wv & 1) * 16 + fr; sw[u] = (k0 == tgt ? 0x3F80u : 0u) | (k0 + 1 == tgt ? 0x3F800000u : 0u); }
    sel = __builtin_bit_cast(bf16x8, (pg8::u32x4){sw[0], sw[1], sw[2], sw[3]}); }
  for (int chain = blockIdx.x; chain < NBATCH * 32 * 2 * 2; chain += gridDim.x) {
    const int half = chain & 1, dir = (chain >> 1) & 1, hv = (chain >> 2) & 31, b = chain >> 7, hk = hv >> 1;
    LDS_BARRIER();
    for (int e = tid_; e < 64 * 136 / 2; e += 512) ((unsigned*)STB)[e] = 0u;
    f32x4 st[4];
#pragma unroll
    for (int et = 0; et < 4; ++et) st[et] = (f32x4){0.f, 0.f, 0.f, 0.f};
    struct Pre { pg8::u32x4 k[2], q[2], v, ti, at; float gci, be, gcl; };
    auto chunk_of = [&](int it) { return dir == 0 ? it : (it < 4 ? 3 - it : GDN_NCH + 3 - it); };
    auto fetch = [&](int it, Pre& P) {
      const int ch = chunk_of(it); const int item = ((b * GDN_NCH + ch) * 32 + hv) * 2 + dir;
      P.gcl = gcbuf[(size_t)item * 64 + 63];
      { const int row = gdn_row(b, ch, dir ? 63 - lane : lane); P.gci = gcbuf[(size_t)item * 64 + lane]; P.be = bt[(size_t)row * 64 + dir * 32 + hv]; }
#pragma unroll
      for (int it2 = 0; it2 < 2; ++it2) { const int pc = tid_ + it2 * 512, i = pc >> 4, dp = (pc & 15) * 8; const int row = gdn_row(b, ch, dir ? 63 - i : i);
        P.k[it2] = *(const pg8::u32x4*)(kn + (size_t)row * 2048 + hk * 128 + dp); P.q[it2] = *(const pg8::u32x4*)(qn + (size_t)row * 2048 + hk * 128 + dp); }
      { const int i = tid_ >> 3, ep = (tid_ & 7) * 8; const int row = gdn_row(b, ch, dir ? 63 - i : i);
        P.v = *(const pg8::u32x4*)(vv + (size_t)row * 4096 + hv * 128 + half * 64 + ep);
        P.ti = *(const pg8::u32x4*)(tinv + (size_t)item * 4096 + i * 64 + ep); P.at = *(const pg8::u32x4*)(attn + (size_t)item * 4096 + i * 64 + ep); }
    };
    Pre P; fetch(0, P);
    f32x4 osave[2];
    auto store_o = [&](int chp) {
#pragma unroll
      for (int tl = 0; tl < 2; ++tl) { const int t = wv * 2 + tl, ti = t >> 2, te = t & 3;
#pragma unroll
        for (int r = 0; r < 4; ++r) { const int i = ti * 16 + fq * 4 + r; const int row = gdn_row(b, chp, dir ? 63 - i : i);
          odir[((size_t)dir * MT + row) * GDN_V + hv * 128 + half * 64 + te * 16 + fr] = f2bf(osave[tl][r]); } }
    };
    for (int it = 0; it < GDN_NCH; ++it) {
      const float gcl = P.gcl;
#pragma unroll
      for (int it2 = 0; it2 < 2; ++it2) { const int pc = tid_ + it2 * 512, i = pc >> 4, dp = (pc & 15) * 8;
        *(pg8::u32x4*)(KR + i * 136 + dp) = P.k[it2]; *(pg8::u32x4*)(QR + i * 136 + dp) = P.q[it2]; }
      { const int i = tid_ >> 3, ep = (tid_ & 7) * 8;
        *(pg8::u32x4*)(VR + i * 72 + ep) = P.v; *(pg8::u32x4*)(TI + i * 72 + ep) = P.ti; *(pg8::u32x4*)(AT + i * 72 + ep) = P.at; }
      if (wv == 0) { EG[lane] = __expf(P.gci); BE[lane] = P.be; EGL[lane] = __expf(gcl - P.gci); }
      LDS_BARRIER();
      fetch(it + 1 < GDN_NCH ? it + 1 : it, P);
      if (it > 0) store_o(chunk_of(it - 1));
      const int ti = wv >> 1;
      const f32x4 eg4 = *(const f32x4*)(EG + ti * 16 + fq * 4), be4 = *(const f32x4*)(BE + ti * 16 + fq * 4);
      f32x4 o1[2];
#pragma unroll
      for (int tl = 0; tl < 2; ++tl) { const int te = (wv & 1) * 2 + tl;
        const bf16_t* Ak = KR + (ti * 16 + fr) * 136 + fq * 8; const bf16_t* Aq = QR + (ti * 16 + fr) * 136 + fq * 8; const bf16_t* B = STB + (te * 16 + fr) * 136 + fq * 8;
        f32x4 ks = {0.f, 0.f, 0.f, 0.f}; f32x4 oq = {0.f, 0.f, 0.f, 0.f};
#pragma unroll
        for (int kk = 0; kk < 4; ++kk) { const bf16x8 bb = *(const bf16x8*)(B + kk * 32);
          ks = __builtin_amdgcn_mfma_f32_16x16x32_bf16(*(const bf16x8*)(Ak + kk * 32), bb, ks, 0, 0, 0); oq = __builtin_amdgcn_mfma_f32_16x16x32_bf16(*(const bf16x8*)(Aq + kk * 32), bb, oq, 0, 0, 0); }
        float r4[4];
#pragma unroll
        for (int r = 0; r < 4; ++r) { const float vr = __uint_as_float((unsigned)VR[(ti * 16 + fq * 4 + r) * 72 + te * 16 + fr] << 16);
          r4[r] = be4[r] * (vr - eg4[r] * ks[r]); oq[r] *= eg4[r] * 0.08838834764831845f; }
        o1[tl] = oq;
        *(u32x2*)(RT + (te * 16 + fr) * 72 + ti * 16 + fq * 4) = (u32x2){pg8::cvt_pk_bf16(r4[0], r4[1]), pg8::cvt_pk_bf16(r4[2], r4[3])}; }
      bf16x8 kt[2];
      { unsigned kw[8];
#pragma unroll
        for (int t4 = 0; t4 < 4; ++t4) { const bf16x8 a = *(const bf16x8*)(KR + (t4 * 16 + fr) * 136 + (wv >> 1) * 32 + fq * 8);
          const f32x4 c = __builtin_amdgcn_mfma_f32_16x16x32_bf16(a, sel, (f32x4){0.f, 0.f, 0.f, 0.f}, 0, 0, 0);
          kw[t4 * 2] = pg8::cvt_pk_bf16(c[0], c[1]); kw[t4 * 2 + 1] = pg8::cvt_pk_bf16(c[2], c[3]); }
        kt[0] = __builtin_bit_cast(bf16x8, (pg8::u32x4){kw[0], kw[1], kw[2], kw[3]}); kt[1] = __builtin_bit_cast(bf16x8, (pg8::u32x4){kw[4], kw[5], kw[6], kw[7]}); }
      LDS_BARRIER();
      const f32x4 egl4 = *(const f32x4*)(EGL + ti * 16 + fq * 4);
#pragma unroll
      for (int tl = 0; tl < 2; ++tl) { const int te = (wv & 1) * 2 + tl;
        const bf16_t* A = TI + (ti * 16 + fr) * 72 + fq * 8; const bf16_t* B = RT + (te * 16 + fr) * 72 + fq * 8;
        f32x4 vn = {0.f, 0.f, 0.f, 0.f};
#pragma unroll
        for (int kk = 0; kk < 2; ++kk) vn = __builtin_amdgcn_mfma_f32_16x16x32_bf16(*(const bf16x8*)(A + kk * 32), *(const bf16x8*)(B + kk * 32), vn, 0, 0, 0);
        *(u32x2*)(VNT + (te * 16 + fr) * 72 + ti * 16 + fq * 4) = (u32x2){pg8::cvt_pk_bf16(vn[0], vn[1]), pg8::cvt_pk_bf16(vn[2], vn[3])};
        *(u32x2*)(VNS + (te * 16 + fr) * 72 + ti * 16 + fq * 4) = (u32x2){pg8::cvt_pk_bf16(vn[0] * egl4[0], vn[1] * egl4[1]), pg8::cvt_pk_bf16(vn[2] * egl4[2], vn[3] * egl4[3])}; }
      LDS_BARRIER();
#pragma unroll
      for (int tl = 0; tl < 2; ++tl) { const int te = (wv & 1) * 2 + tl;
        const bf16_t* A = AT + (ti * 16 + fr) * 72 + fq * 8; const bf16_t* B = VNT + (te * 16 + fr) * 72 + fq * 8;
        f32x4 o = o1[tl];
#pragma unroll
        for (int kk = 0; kk < 2; ++kk) o = __builtin_amdgcn_mfma_f32_16x16x32_bf16(*(const bf16x8*)(A + kk * 32), *(const bf16x8*)(B + kk * 32), o, 0, 0, 0);
        osave[tl] = o; }
      const float gl = __expf(gcl);
#pragma unroll
      for (int et = 0; et < 4; ++et) { const bf16_t* Bv = VNS + (et * 16 + fr) * 72 + fq * 4;
        f32x4 a = st[et] * gl;
#pragma unroll
        for (int kk = 0; kk < 2; ++kk) { const u32x2 lo = *(const u32x2*)(Bv + kk * 32), hi = *(const u32x2*)(Bv + kk * 32 + 16);
          a = __builtin_amdgcn_mfma_f32_16x16x32_bf16(kt[kk], __builtin_bit_cast(bf16x8, (pg8::u32x4){lo[0], lo[1], hi[0], hi[1]}), a, 0, 0, 0); }
        st[et] = a;
        *(u32x2*)(STB + (et * 16 + fr) * 136 + wv * 16 + fq * 4) = (u32x2){pg8::cvt_pk_bf16(a[0], a[1]), pg8::cvt_pk_bf16(a[2], a[3])}; }
      LDS_BARRIER();
    }
    store_o(chunk_of(GDN_NCH - 1));
  }
}
__device__ __forceinline__ void k_gdn_gate2(int wv, const bf16_t* __restrict__ odir, const bf16_t* __restrict__ proj, const float* __restrict__ norm_g, bf16_t* __restrict__ og) {
  const int lane = lane_opq(), tid_ = wv * 64 + lane;
  constexpr int RPB = MT / 256;
  const int ch0 = tid_ * 8;
  float ng[8];
#pragma unroll
  for (int q = 0; q < 8; ++q) ng[q] = norm_g[(ch0 & 127) + q];
  for (int rb = blockIdx.x * RPB; rb < MT; rb += gridDim.x * RPB) {
    for (int r0 = rb; r0 < rb + RPB; r0 += 2) {
      pg8::u32x4 oa[2], ob[2], zz[2];
#pragma unroll
      for (int ro = 0; ro < 2; ++ro) { const size_t row = r0 + ro;
        oa[ro] = *(const pg8::u32x4*)(odir + row * GDN_V + ch0); ob[ro] = *(const pg8::u32x4*)(odir + ((size_t)MT + row) * GDN_V + ch0);
        zz[ro] = *(const pg8::u32x4*)(proj + row * 12288 + GDN_CONV + ch0); }
#pragma unroll
      for (int ro = 0; ro < 2; ++ro) { const size_t row = r0 + ro;
        float o[8], z[8]; float ss = 0.f;
#pragma unroll
        for (int q = 0; q < 4; ++q) { o[2 * q] = __uint_as_float(oa[ro][q] << 16) + __uint_as_float(ob[ro][q] << 16); o[2 * q + 1] = __uint_as_float(oa[ro][q] & 0xFFFF0000u) + __uint_as_float(ob[ro][q] & 0xFFFF0000u);
          z[2 * q] = __uint_as_float(zz[ro][q] << 16); z[2 * q + 1] = __uint_as_float(zz[ro][q] & 0xFFFF0000u); ss += o[2 * q] * o[2 * q] + o[2 * q + 1] * o[2 * q + 1]; }
        ss += __int_as_float(__builtin_amdgcn_ds_bpermute((lane ^ 1) << 2, __float_as_int(ss)));
        ss += __int_as_float(__builtin_amdgcn_ds_bpermute((lane ^ 2) << 2, __float_as_int(ss)));
        ss += __int_as_float(__builtin_amdgcn_ds_bpermute((lane ^ 4) << 2, __float_as_int(ss)));
        ss += __int_as_float(__builtin_amdgcn_ds_bpermute((lane ^ 8) << 2, __float_as_int(ss)));
        const float r = rsqrtf(ss * (1.0f / 128.0f) + 1e-6f);
        unsigned w4[4];
#pragma unroll
        for (int q = 0; q < 4; ++q) w4[q] = pg8::cvt_pk_bf16(o[2 * q] * r * ng[2 * q] * fsilu(z[2 * q]), o[2 * q + 1] * r * ng[2 * q + 1] * fsilu(z[2 * q + 1]));
        *(pg8::u32x4*)(og + row * GDN_V + ch0) = (pg8::u32x4){w4[0], w4[1], w4[2], w4[3]};
      }
    }
  }
}

__device__ __forceinline__ void k_gdn_conv(int wv, const float* proj, const float* cw, float* qkv) {
  const size_t n = (size_t)MT * GDN_CONV;
  for (size_t i = (size_t)blockIdx.x * blockDim.x + otid(wv); i < n; i += (size_t)gridDim.x * blockDim.x) {
    const int row = (int)(i / GDN_CONV), col = (int)(i % GDN_CONV);
    int t, len;
    if (row < ML) { t = row % SEQ; len = SEQ; } else { t = (row - ML) % CTXL; len = CTXL; }
    float a = 0.f;
#pragma unroll
    for (int k = 0; k < 5; ++k) { const int tt = t + k - 2; if (tt >= 0 && tt < len) a += proj[(size_t)(row + k - 2) * GDN_LD + col] * cw[k * GDN_CONV + col]; }
    qkv[i] = silu_f(a);
  }
}
__device__ __forceinline__ void k_gdn_l2(int wv, float* qkv) {
  const int lane = otid(wv) & 63;
  const size_t wave = ((size_t)blockIdx.x * blockDim.x + otid(wv)) >> 6, nw = ((size_t)gridDim.x * blockDim.x) >> 6;
  for (size_t item = wave; item < (size_t)MT * 32; item += nw) {
    float* p = qkv + (item / 32) * GDN_CONV + (item % 32) * 128;
    const float a = p[lane], b = p[lane + 64];
    const float ss = wave_sum(a * a + b * b);
    const float r = rsqrtf(ss + 1e-6f);
    p[lane] = a * r; p[lane + 64] = b * r;
  }
}
__device__ __forceinline__ void k_gdn_gates(int wv, const float* proj, const float* a_log, const float* dt_bias, float* gg, float* bt) {
  const size_t n = (size_t)MT * 64;
  for (size_t i = (size_t)blockIdx.x * blockDim.x + otid(wv); i < n; i += (size_t)gridDim.x * blockDim.x) {
    const int row = (int)(i / 64), j = (int)(i % 64);
    const float a = proj[(size_t)row * GDN_LD + GDN_CONV + GDN_V + j], b = proj[(size_t)row * GDN_LD + GDN_CONV + GDN_V + 64 + j];
    const float xx = a + dt_bias[j];
    const float sp = xx > 20.f ? xx : log1pf(expf(xx));
    gg[i] = -expf(a_log[j]) * sp;
    bt[i] = sigmoid_f(b);
  }
}
__device__ __forceinline__ void k_gdn_rec(int wv, const float* __restrict__ qkv, const float* __restrict__ gg, const float* __restrict__ bt, float* odir) {
  int tid_ = otid(wv);
  float* red = (float*)dyn_lds();
  const int e = tid_ & 127, qd = tid_ >> 7;
  __syncthreads();
  for (int item = blockIdx.x; item < NBATCH * 32 * 2; item += gridDim.x) {
    const int dir = item & 1, hv = (item >> 1) & 31, b = item >> 6, hk = hv >> 1;
    float S[32];
#pragma unroll
    for (int d = 0; d < 32; ++d) S[d] = 0.f;
    for (int s = 0; s < CTXL + SEQ; ++s) {
      int row;
      if (s < CTXL) { const int t = dir ? CTXL - 1 - s : s; row = ML + b * CTXL + t; }
      else { int q = s - CTXL; if (dir) q = SEQ - 1 - q; row = b * SEQ + q; }
      const float* qp = qkv + (size_t)row * GDN_CONV + hk * 128 + qd * 32;
      const float* kp = qkv + (size_t)row * GDN_CONV + 2048 + hk * 128 + qd * 32;
      const float v = qkv[(size_t)row * GDN_CONV + 4096 + hv * 128 + e];
      const float a = expf(gg[(size_t)row * 64 + dir * 32 + hv]), beta = bt[(size_t)row * 64 + dir * 32 + hv];
      float dot = 0.f;
#pragma unroll
      for (int d = 0; d < 32; ++d) { S[d] *= a; dot += S[d] * kp[d]; }
      red[qd * 128 + e] = dot;
      __syncthreads();
      dot = (red[e] + red[128 + e]) + (red[256 + e] + red[384 + e]);
      const float vn = beta * (v - dot);
      float o = 0.f;
#pragma unroll
      for (int d = 0; d < 32; ++d) { S[d] += kp[d] * vn; o += S[d] * qp[d]; }
      red[(4 + qd) * 128 + e] = o;
      __syncthreads();
      if (qd == 0) odir[((size_t)dir * MT + row) * GDN_V + hv * 128 + e] = ((red[512 + e] + red[640 + e]) + (red[768 + e] + red[896 + e])) * 0.08838834764831845f;
    }
  }
}
__device__ __forceinline__ void k_gdn_gate(int wv, const float* odir, const float* proj, const float* norm_g, float* og) {
  int tid_ = otid(wv);
  const int lane = tid_ & 63;
  const size_t wave = ((size_t)blockIdx.x * blockDim.x + tid_) >> 6, nw = ((size_t)gridDim.x * blockDim.x) >> 6;
  for (size_t item = wave; item < (size_t)MT * 32; item += nw) {
    const size_t row = item / 32; const int hv = (int)(item % 32);
    const size_t o0 = row * GDN_V + hv * 128, o1 = ((size_t)MT + row) * GDN_V + hv * 128;
    const float a = odir[o0 + lane] + odir[o1 + lane], b = odir[o0 + lane + 64] + odir[o1 + lane + 64];
    const float ms = wave_sum(a * a + b * b) * (1.0f / 128.0f);
    const float r = rsqrtf(ms + 1e-6f);
    const float za = proj[row * GDN_LD + GDN_CONV + hv * 128 + lane], zb = proj[row * GDN_LD + GDN_CONV + hv * 128 + lane + 64];
    og[o0 + lane] = a * r * norm_g[lane] * silu_f(za);
    og[o0 + lane + 64] = b * r * norm_g[lane + 64] * silu_f(zb);
  }
}

__device__ __forceinline__ int stream_of_pm(int pm) { return pm < 16 ? 0 : (pm < 32 ? 1 : 2); }

__device__ __forceinline__ void k_cvt_t(int wv, const float* __restrict__ W, int ldw, int K, int ncols, bf16_t* __restrict__ dst, int mode, int off, int first = 0, int nb = 0) {
  int tid_ = otid(wv);
  float* T = (float*)dyn_lds();
  const int col4 = tid_ & 127, kr = tid_ >> 7, lane = tid_ & 63, kp = lane & 31, csel = lane >> 5;
  const int tk = K / 64, tc = (ncols + 511) / 512;
  if (nb == 0) nb = gridDim.x;
  if ((int)blockIdx.x < first || (int)blockIdx.x >= first + nb) return;
  const int ntile = tk * tc;
  int t = blockIdx.x - first;
  if (t >= ntile) return;
  f32x4 v[16];
  auto issue = [&](int tt) { const int k0 = (tt / tc) * 64, c0 = (tt % tc) * 512; const int c = c0 + 4 * col4; const int cl = c < ncols ? c : 0;
#pragma unroll
    for (int q = 0; q < 16; ++q) v[q] = *(const f32x4*)(W + (size_t)(k0 + kr + 4 * q) * ldw + cl); };
  issue(t);
  for (; t < ntile; t += nb) {
    const int k0 = (t / tc) * 64, c0 = (t % tc) * 512;
    __syncthreads();
#pragma unroll
    for (int q = 0; q < 16; ++q) *(f32x4*)(T + (kr + 4 * q) * 516 + 4 * col4) = v[q];
    __syncthreads();
    if (t + nb < ntile) issue(t + nb);
#pragma unroll 8
    for (int q = 0; q < 32; ++q) { const int cc = wv * 64 + 2 * q + csel, gc = c0 + cc;
      if (gc < ncols) { const float a = T[(2 * kp) * 516 + cc], b = T[(2 * kp + 1) * 516 + cc];
        const int r = mode ? ((gc >> 4) * 32 + (gc & 15) + off) : gc;
        *(unsigned*)(dst + (size_t)r * K + k0 + 2 * kp) = pg8::cvt_pk_bf16(a, b); } }
  }
}
__device__ __forceinline__ void k_zero_bf16(int wv, bf16_t* p, size_t n) { for (size_t i = (size_t)blockIdx.x * blockDim.x + otid(wv); i < n; i += (size_t)gridDim.x * blockDim.x) p[i] = 0; }
__device__ __forceinline__ void k_f2bf(int wv, const float* a, bf16_t* o, size_t n) { for (size_t i = (size_t)blockIdx.x * blockDim.x + otid(wv); i < n; i += (size_t)gridDim.x * blockDim.x) o[i] = f2bf(a[i]); }

struct EpiStoreF32 {
  static constexpr bool PERM = false, AFTER_DRAIN = false;
  float* C; const float* bias; int ldc, pad_;
  __device__ __forceinline__ void operator()(const f32x4 (&acc)[2][2][4][2], const Unit& u, int wr, int wc, int fr, int fq) const {
    const int row0 = u.pm * 256 + wr * 64 + fr, col0 = u.pn * 256 + wc * 32 + 4 * fq;
#pragma unroll
    for (int ai = 0; ai < 2; ++ai)
#pragma unroll
      for (int m = 0; m < 4; ++m) { float* rowp = C + (size_t)(row0 + ai * 128 + m * 16) * ldc + col0;
#pragma unroll
        for (int bj = 0; bj < 2; ++bj)
#pragma unroll
          for (int n = 0; n < 2; ++n) { f32x4 v = acc[ai][bj][m][n]; if (bias) v += *(const f32x4*)(bias + col0 + bj * 128 + n * 16); *(f32x4*)(rowp + bj * 128 + n * 16) = v; } }
  }
};
struct EpiStoreRowBias {
  static constexpr bool PERM = false, AFTER_DRAIN = false;
  float* C; const float* bias; int ldc, pad_;
  __device__ __forceinline__ void operator()(const f32x4 (&acc)[2][2][4][2], const Unit& u, int wr, int wc, int fr, int fq) const {
    const int row0 = u.pm * 256 + wr * 64 + fr, col0 = u.pn * 256 + wc * 32 + 4 * fq;
#pragma unroll
    for (int ai = 0; ai < 2; ++ai)
#pragma unroll
      for (int m = 0; m < 4; ++m) { const int row = row0 + ai * 128 + m * 16; float* rowp = C + (size_t)row * ldc + col0; const float b = bias[row];
#pragma unroll
        for (int bj = 0; bj < 2; ++bj)
#pragma unroll
          for (int n = 0; n < 2; ++n) { f32x4 v = acc[ai][bj][m][n]; v += b; *(f32x4*)(rowp + bj * 128 + n * 16) = v; } }
  }
};
struct EpiFilt {
  static constexpr bool PERM = false, AFTER_DRAIN = false;
  float* C; int ldc, pad_;
  __device__ __forceinline__ void operator()(const f32x4 (&acc)[2][2][4][2], const Unit& u, int wr, int wc, int fr, int fq) const {
    const int row0 = u.pm * 256 + wr * 64 + fr, col0 = u.pn * 256 + wc * 32 + 4 * fq;
    const float mind = -3.0701134573253945f, maxd = -15.350567286626973f;
#pragma unroll
    for (int ai = 0; ai < 2; ++ai)
#pragma unroll
      for (int m = 0; m < 4; ++m) { const int row = row0 + ai * 128 + m * 16; float* rowp = C + (size_t)row * ldc + col0;
        const float delta = fabsf(mind + (maxd - mind) * (float)(row & (D - 1)) / (float)(D - 1));
#pragma unroll
        for (int bj = 0; bj < 2; ++bj)
#pragma unroll
          for (int n = 0; n < 2; ++n) { f32x4 v = acc[ai][bj][m][n];
#pragma unroll
            for (int jj = 0; jj < 4; ++jj) { const int tt = col0 + bj * 128 + n * 16 + jj; const float tu = tt < SEQ ? (float)tt * (1.0f / (float)(SEQ - 1)) : (float)(tt - SEQ) * (1.0f / (float)(CTXL - 1)); v[jj] *= __expf(-tu * delta); }
            *(f32x4*)(rowp + bj * 128 + n * 16) = v; } }
  }
};
struct EpiProj {
  static constexpr bool PERM = false, AFTER_DRAIN = false;
  bf16_t* Pb; float* Gab;
  __device__ __forceinline__ void operator()(const f32x4 (&acc)[2][2][4][2], const Unit& u, int wr, int wc, int fr, int fq) const {
    const int row0 = u.pm * 256 + wr * 64 + fr, col0 = u.pn * 256 + wc * 32 + 4 * fq;
    if (u.pn == 48) {
#pragma unroll
      for (int ai = 0; ai < 2; ++ai)
#pragma unroll
        for (int m = 0; m < 4; ++m) { float* rowp = Gab + (size_t)(row0 + ai * 128 + m * 16) * 256 + (col0 - 12288);
#pragma unroll
          for (int bj = 0; bj < 2; ++bj)
#pragma unroll
            for (int n = 0; n < 2; ++n) *(f32x4*)(rowp + bj * 128 + n * 16) = acc[ai][bj][m][n]; }
    } else {
#pragma unroll
      for (int ai = 0; ai < 2; ++ai)
#pragma unroll
        for (int m = 0; m < 4; ++m) { bf16_t* rowp = Pb + (size_t)(row0 + ai * 128 + m * 16) * 12288 + col0;
#pragma unroll
          for (int bj = 0; bj < 2; ++bj)
#pragma unroll
            for (int n = 0; n < 2; ++n) { const f32x4 v = acc[ai][bj][m][n] + 0.0f;
              *(u32x2*)(rowp + bj * 128 + n * 16) = (u32x2){pg8::cvt_pk_bf16(v[0], v[1]), pg8::cvt_pk_bf16(v[2], v[3])}; } }
    }
  }
};
struct EpiSwiglu {
  static constexpr bool PERM = false, AFTER_DRAIN = false;
  bf16_t* O; int ldo, pad_;
  __device__ __forceinline__ void operator()(const f32x4 (&acc)[2][2][4][2], const Unit& u, int wr, int wc, int fr, int fq) const {
    const int row0 = u.pm * 256 + wr * 64 + fr;
#pragma unroll
    for (int ai = 0; ai < 2; ++ai)
#pragma unroll
      for (int m = 0; m < 4; ++m) { bf16_t* rowp = O + (size_t)(row0 + ai * 128 + m * 16) * ldo;
#pragma unroll
        for (int bj = 0; bj < 2; ++bj) { const int q = u.pn * 8 + bj * 4 + wc; const f32x4 g = acc[ai][bj][m][0], up = acc[ai][bj][m][1];
          u32x2 w; w.x = pg8::cvt_pk_bf16(fsilu(g[0]) * up[0], fsilu(g[1]) * up[1]); w.y = pg8::cvt_pk_bf16(fsilu(g[2]) * up[2], fsilu(g[3]) * up[3]);
          *(u32x2*)(rowp + q * 16 + 4 * fq) = w; } }
  }
};
struct EpiResid {
  static constexpr bool PERM = false, AFTER_DRAIN = false;
  float* X; const float* modl; const float* bias; int gi, pad_;
  __device__ __forceinline__ void operator()(const f32x4 (&acc)[2][2][4][2], const Unit& u, int wr, int wc, int fr, int fq) const {
    const int row0 = u.pm * 256 + wr * 64 + fr, col0 = u.pn * 256 + wc * 32 + 4 * fq;
    const float* gate = modl + (size_t)stream_of_pm(u.pm) * NMOD + gi * D;
#pragma unroll
    for (int bj = 0; bj < 2; ++bj)
#pragma unroll
      for (int n = 0; n < 2; ++n) { const int col = col0 + bj * 128 + n * 16; const f32x4 gv = *(const f32x4*)(gate + col);
        f32x4 bv = {0.f, 0.f, 0.f, 0.f}; if (bias) bv = *(const f32x4*)(bias + col);
#pragma unroll
        for (int ai = 0; ai < 2; ++ai)
#pragma unroll
          for (int m = 0; m < 4; ++m) { float* p = X + (size_t)(row0 + ai * 128 + m * 16) * D + col; f32x4 xv = *(f32x4*)p; xv += gv * (acc[ai][bj][m][n] + bv); *(f32x4*)p = xv; } }
  }
};
struct EpiGlu {
  static constexpr bool PERM = false, AFTER_DRAIN = false;
  float* X; const float* Xlat; const float* Xctx; const float* modl; const float* bias; int gi, pad_;
  __device__ __forceinline__ void operator()(const f32x4 (&acc)[2][2][4][2], const Unit& u, int wr, int wc, int fr, int fq) const {
    const int row0 = u.pm * 256 + wr * 64 + fr;
    const float* gate = modl + (size_t)stream_of_pm(u.pm) * NMOD + gi * D;
    const float* Xs = u.pm < ML / 256 ? Xlat : Xctx - (size_t)ML * D;
#pragma unroll
    for (int bj = 0; bj < 2; ++bj) { const int col = (u.pn * 8 + bj * 4 + wc) * 16 + 4 * fq;
      const f32x4 gv = *(const f32x4*)(gate + col), bv = *(const f32x4*)(bias + col), bg = *(const f32x4*)(bias + D + col);
#pragma unroll
      for (int ai = 0; ai < 2; ++ai)
#pragma unroll
        for (int m = 0; m < 4; ++m) { const size_t eo = (size_t)(row0 + ai * 128 + m * 16) * D + col; float* p = X + eo; f32x4 xv = *(const f32x4*)(Xs + eo);
          const f32x4 v = acc[ai][bj][m][0] + bv, g = acc[ai][bj][m][1] + bg;
#pragma unroll
          for (int j = 0; j < 4; ++j) xv[j] += gv[j] * v[j] * fsigmoid(g[j]);
          *(f32x4*)p = xv; } }
  }
};

template <class Epi> __device__ __forceinline__ void gemm_ph(int wv, pg8::Gemm g, Epi E) {
  __syncthreads();
  pg8::StaticOrder S; S.init(g.M, g.N, gridDim.x, blockIdx.x);
  pg8::gemm_phase<Epi, pg8::StaticOrder, false>((PG8_LAS unsigned char*)dyn_lds(), g, S, E, nullptr, wv);
  __syncthreads();
}
struct EpiPartial {
  static constexpr bool PERM = false, AFTER_DRAIN = false;
  float* P; int pad0_, pad1_;
  __device__ __forceinline__ void operator()(const f32x4 (&acc)[2][2][4][2], const Unit& u, int wr, int wc, int fr, int fq) const {
    const int row0 = (u.koff >> 10) * MC + u.pm * 256 + wr * 64 + fr, col0 = u.pn * 256 + wc * 32 + 4 * fq;
#pragma unroll
    for (int ai = 0; ai < 2; ++ai)
#pragma unroll
      for (int m = 0; m < 4; ++m) { float* rowp = P + (size_t)(row0 + ai * 128 + m * 16) * D + col0;
#pragma unroll
        for (int bj = 0; bj < 2; ++bj)
#pragma unroll
          for (int n = 0; n < 2; ++n) *(f32x4*)(rowp + bj * 128 + n * 16) = acc[ai][bj][m][n]; }
  }
};
__device__ __forceinline__ void gemm_ctx_splitk(int wv, const bf16_t* A, const bf16_t* Bt, int Ktot, EpiPartial E) {
  __syncthreads();
  pg8::Gemm g; g.A = A; g.Bt = Bt; g.M = MC; g.N = D; g.K = 512; g.ld = Ktot;
  pg8::SplitKOrder S; S.init(MC, D, Ktot / 512, 512, gridDim.x, blockIdx.x);
  pg8::gemm_phase<EpiPartial, pg8::SplitKOrder, false>((PG8_LAS unsigned char*)dyn_lds(), g, S, E, nullptr, wv);
  __syncthreads();
}
__device__ __forceinline__ pg8::Gemm mkg(const bf16_t* A, const bf16_t* Bt, int M, int N, int K) { pg8::Gemm g; g.A = A; g.Bt = Bt; g.M = M; g.N = N; g.K = K; g.ld = K; return g; }

struct Params {
  const float *x, *cvec, *ctx, *c_ctx, *ada_w, *ada_b, *norm_g, *final_g, *ffn_wg, *ffn_wu, *ffn_wd;
  const float *s5_a_re, *s5_a_im, *s5_log_dt, *s5_b_re, *s5_b_im, *s5_c_re, *s5_c_im, *s5_d, *s5_glu_w, *s5_glu_b;
  const float *hy_in_w, *hy_in_b, *hy_conv_w, *hy_conv_b, *hy_f_w1, *hy_f_b1, *hy_f_w2, *hy_f_b2, *hy_f_w3, *hy_f_b3, *hy_f_w4, *hy_f_freq, *hy_bias, *hy_out_w, *hy_out_b;
  const float *gdn_in_w, *gdn_conv_w, *gdn_a_log, *gdn_dt_bias, *gdn_norm_g, *gdn_out_w;
  float *out, *sv, *mod, *modp, *xb, *hb, *B1, *B2, *B3, *B4, *raw, *hdn3, *fnorm, *gg, *bt;
  bf16_t *hbb, *Ab, *Wgu, *Wd, *Wm1, *Wm2;
  unsigned* bar;
};
constexpr int LDS_WORK = 2 * FFT_BUF_BYTES + 256, LDS_TOTAL = LDS_WORK + 64;
static_assert(LDS_WORK >= 131072, "gemm stage");

template <int i> __device__ __forceinline__ void cvt_ffn_gu(int wv, const Params& p, int first) {
  k_cvt_t(wv, p.ffn_wg + (size_t)i * D * DFF, DFF, D, DFF, p.Wgu, 1, 0, first, 256 - first); k_cvt_t(wv, p.ffn_wu + (size_t)i * D * DFF, DFF, D, DFF, p.Wgu, 1, 16, first, 256 - first);
}
template <int i> __device__ __forceinline__ void cvt_ffn_d(int wv, const Params& p, int first) { k_cvt_t(wv, p.ffn_wd + (size_t)i * DFF * D, D, DFF, D, p.Wd, 0, 0, first, 256 - first); }
#define SYNC() xcd_barrier(bar, wv)
template <int i> __device__ __forceinline__ void layer(const Params& p, const XcdBarrier& bar, int wv) {
  {
    constexpr int kind = i % 3, j = i / 3, col_major = (j % 2) == 1;
    const float* modl = p.mod + (size_t)i * 3 * NMOD;
    Pend pd0 = {nullptr, nullptr, nullptr, 0};
    if constexpr (i > 0) pd0 = Pend{p.B4, p.mod + (size_t)(i - 1) * 3 * NMOD + (size_t)2 * NMOD + 5 * D, nullptr, DFF / 512};
    if constexpr (kind != 0) k_modnorm<(i > 0) ? DFF / 512 : 0>(wv, p.xb, p.norm_g + (size_t)(i * 2 + 0) * D, modl, 0, 1, nullptr, p.hbb, MT, pd0);
    if constexpr (kind == 0) {
      const size_t o1 = (size_t)j * 2 * G * P, o2 = (size_t)j * 2 * G, o3 = (size_t)j * 2 * G * P * HG;
      const float* gw = p.s5_glu_w + (size_t)j * D * 2 * D;
      bf16_t* UH = (bf16_t*)p.B2; bf16_t* Pt = (bf16_t*)(j == 0 ? p.B3 : p.hb); bf16_t* TQt = Pt + (size_t)G * 256 * 256;
      k_cvt_t(wv, gw, 2 * D, D, D, p.Wm1, 1, 0); k_cvt_t(wv, gw + D, 2 * D, D, D, p.Wm1, 1, 16);
      k_s5_modnorm<(i > 0) ? DFF / 512 : 0>(wv, i == 0 ? (float*)p.x : p.xb, i == 0 ? p.ctx : nullptr, p.norm_g + (size_t)(i * 2 + 0) * D, modl, UH, col_major, pd0);
      SYNC();
      k_s5_scanmm(wv, p.s5_a_re + o1, p.s5_a_im + o1, p.s5_log_dt + o2, Pt, UH);
      SYNC();
      k_s5_outmm(wv, TQt, UH, p.Ab, col_major);
      SYNC();
      { EpiGlu e = {p.xb, i == 0 ? p.x : p.xb, i == 0 ? p.ctx : p.xb + (size_t)ML * D, modl, p.s5_glu_b + (size_t)j * 2 * D, 2, 0}; gemm_ph<EpiGlu>(wv, mkg(p.Ab, p.Wm1, (i < DEPTH - 1) ? MT : ML, 2 * D, D), e); }
      if constexpr (i == 0) { cvt_ffn_gu<i>(wv, p, (MT / 256) * (2 * D / 256) % 256); cvt_ffn_d<i>(wv, p, (MT / 256) * (2 * D / 256) % 256); }
      SYNC();
    } else if constexpr (kind == 1) {
      float* uT = p.B1; float* zT = p.B4;
      k_cvt_t(wv, p.hy_in_w, 3 * D, D, 3 * D, p.Wm1, 0, 0); k_cvt_t(wv, p.hy_out_w, D, D, D, p.Wm2, 0, 0);
      k_hy_hdn(wv, p.hy_f_w1, p.hy_f_b1, p.hy_f_w2, p.hy_f_b2, p.hy_f_w3, p.hy_f_b3, p.hy_f_freq, p.hdn3);
      k_hy_w4prep(wv, p.hy_f_w4, (bf16_t*)p.B2);
      SYNC();
      { EpiFilt e = {p.raw, HY_RAW_LD, 0}; gemm_ph<EpiFilt>(wv, mkg((const bf16_t*)p.B2, (const bf16_t*)p.hdn3, 8192, HY_RAW_LD, 256), e); }
      { EpiStoreRowBias e = {uT, p.hy_in_b, MT, 0}; gemm_ph<EpiStoreRowBias>(wv, mkg(p.Wm1, p.hbb, 3 * D, MT, D), e); }
      cvt_ffn_gu<i>(wv, p, (3 * D / 256) * (MT / 256) % 256); cvt_ffn_d<i>(wv, p, (3 * D / 256) * (MT / 256) % 256);
      SYNC();
      k_hy_fftconv(wv, uT, p.raw, p.hy_conv_w, p.hy_conv_b, p.hy_bias, zT);
      SYNC();
      k_cvt_t(wv, zT, MT, D, MT, p.Ab, 0, 0);
      SYNC();
      { EpiResid e = {p.xb, modl, p.hy_out_b, 2, 0}; gemm_ph<EpiResid>(wv, mkg(p.Ab, p.Wm2, ML, D, D), e); }
      { EpiPartial e = {p.B4, 0, 0}; gemm_ctx_splitk(wv, p.Ab + (size_t)ML * D, p.Wm2, D, e); }
      SYNC();
    } else {
      bf16_t* proj = (bf16_t*)p.B1; float* gab = (float*)(proj + (size_t)MT * 12288); bf16_t* odir = (bf16_t*)p.B3;
      bf16_t* qn = (bf16_t*)p.B2; bf16_t* kn = qn + (size_t)MT * 2048; bf16_t* vv = kn + (size_t)MT * 2048; float* gcbuf = (float*)(vv + (size_t)MT * 4096);
      bf16_t* tinv = (bf16_t*)p.B4; bf16_t* attn = tinv + (size_t)GDN_ITEMS * 4096;
      k_cvt_t(wv, p.gdn_in_w, GDN_PROJ, D, GDN_PROJ, p.Wm1, 0, 0);
      k_zero_bf16(wv, p.Wm1 + (size_t)GDN_PROJ * D, (size_t)(GDN_LD - GDN_PROJ) * D);
      k_cvt_t(wv, p.gdn_out_w, D, GDN_V, D, p.Wm2, 0, 0);
      SYNC();
      { EpiProj e = {proj, gab}; gemm_ph<EpiProj>(wv, mkg(p.hbb, p.Wm1, MT, GDN_LD, D), e); }
      cvt_ffn_gu<i>(wv, p, (MT / 256) * (GDN_LD / 256) % 256);
      SYNC();
      k_gdn_feat(wv, proj, gab, p.gdn_conv_w, p.gdn_a_log, p.gdn_dt_bias, qn, kn, vv, p.gg, p.bt);
      SYNC();
      k_gdn_prep(wv, qn, kn, p.gg, p.bt, tinv, attn, gcbuf);
      SYNC();
      k_gdn_chain(wv, qn, kn, vv, p.bt, tinv, attn, gcbuf, odir);
      SYNC();
      k_gdn_gate2(wv, odir, proj, p.gdn_norm_g, p.Ab);
      SYNC();
      { EpiResid e = {p.xb, modl, nullptr, 2, 0}; gemm_ph<EpiResid>(wv, mkg(p.Ab, p.Wm2, ML, D, GDN_V), e); }
      { EpiPartial e = {p.B4, 0, 0}; gemm_ctx_splitk(wv, p.Ab + (size_t)ML * GDN_V, p.Wm2, GDN_V, e); }
      SYNC();
    }
    if constexpr (i == DEPTH - 1) cvt_ffn_gu<i>(wv, p, 0);
    Pend pd1 = {nullptr, nullptr, nullptr, 0};
    if constexpr (kind == 1) pd1 = Pend{p.B4, modl + (size_t)2 * NMOD + 2 * D, p.hy_out_b, D / 512};
    if constexpr (kind == 2) pd1 = Pend{p.B4, modl + (size_t)2 * NMOD + 2 * D, nullptr, GDN_V / 512};
    k_modnorm<kind == 1 ? D / 512 : (kind == 2 ? GDN_V / 512 : 0)>(wv, p.xb, p.norm_g + (size_t)(i * 2 + 1) * D, modl, 3, 4, nullptr, p.hbb, MT, pd1);
    SYNC();
    constexpr int MF = (i < DEPTH - 1) ? MT : ML;
    { EpiSwiglu e = {p.Ab, DFF, 0}; gemm_ph<EpiSwiglu>(wv, mkg(p.hbb, p.Wgu, MF, 2 * DFF, D), e); }
    if constexpr (i >= 2) cvt_ffn_d<i>(wv, p, (MF / 256) * (2 * DFF / 256) % 256);
    SYNC();
    { EpiResid e = {p.xb, modl, nullptr, 5, 0}; gemm_ph<EpiResid>(wv, mkg(p.Ab, p.Wd, ML, D, DFF), e); }
    if constexpr (i < DEPTH - 1) { EpiPartial e = {p.B4, 0, 0}; gemm_ctx_splitk(wv, p.Ab + (size_t)ML * DFF, p.Wd, DFF, e); }
    SYNC();
  }
}

__global__ __launch_bounds__(512, 2) void fwd(Params p) {
  extern __shared__ __attribute__((aligned(16))) unsigned char shm[];
  const int wv = __builtin_amdgcn_readfirstlane((int)threadIdx.x >> 6);
  volatile LAS unsigned* st = (volatile LAS unsigned*)(shm + LDS_WORK);
  if (threadIdx.x == 0) { st[0] = 0u; st[1] = 0u; st[2] = 0u; st[3] = 0u; }
  __syncthreads();
  XcdBarrier bar = xcd_barrier_post(p.bar, st);
  {
    S5W w0, w1;
    { const size_t o1 = 0, o2 = 0, o3 = 0; bf16_t* Pt = (bf16_t*)p.B3;
      w0 = S5W{p.s5_a_re + o1, p.s5_a_im + o1, p.s5_log_dt + o2, p.s5_b_re + o3, p.s5_b_im + o3, p.s5_c_re + o3, p.s5_c_im + o3, p.s5_d, Pt, Pt + (size_t)G * 256 * 256}; }
    { const size_t o1 = (size_t)2 * G * P, o2 = (size_t)2 * G, o3 = (size_t)2 * G * P * HG; bf16_t* Pt = (bf16_t*)p.hb;
      w1 = S5W{p.s5_a_re + o1, p.s5_a_im + o1, p.s5_log_dt + o2, p.s5_b_re + o3, p.s5_b_im + o3, p.s5_c_re + o3, p.s5_c_im + o3, p.s5_d + D, Pt, Pt + (size_t)G * 256 * 256}; }
    k_s5_ops(wv, w0, w1);
  }
  k_mod_partial(wv, p.cvec, p.c_ctx, p.ada_w, p.modp);
  SYNC();
  k_mod_reduce(wv, p.modp, p.ada_b, p.mod);
  SYNC();
  layer<0>(p, bar, wv); layer<1>(p, bar, wv); layer<2>(p, bar, wv); layer<3>(p, bar, wv);
  k_final(wv, p.xb, p.final_g, p.out, ML);
}
}

extern "C" void kernel_launch(void* const* d_in, const int* in_sizes, int n_in, void* d_out, int out_size, void* d_ws, size_t ws_size, hipStream_t stream) {
  Params p; memset(&p, 0, sizeof(p));
  const float** ins = (const float**)&p;
  for (int i = 0; i < 42; ++i) ins[i] = (const float*)d_in[i];
  p.out = (float*)d_out;
  float* ws = (float*)d_ws; size_t off = 0;
  auto take = [&](size_t n) { float* q = ws + off; off += (n + 63) & ~(size_t)63; return q; };
  auto takeb = [&](size_t n) { return (bf16_t*)take((n + 1) / 2); };
  p.bar = (unsigned*)take(XCD_BAR_WORDS);
  p.sv = take(3 * D);
  p.mod = take((size_t)DEPTH * 3 * NMOD);
  p.modp = take((size_t)MOD_NS * DEPTH * 3 * NMOD);
  p.xb = take((size_t)MT * D);
  p.hb = take((size_t)MT * D);
  p.hbb = takeb((size_t)MT * D);
  p.B1 = take((size_t)MT * GDN_LD);
  p.B2 = take((size_t)MT * GDN_CONV);
  p.B3 = take((size_t)2 * MT * GDN_V);
  p.B4 = take((size_t)MT * GDN_V);
  p.Ab = takeb((size_t)MT * DFF);
  p.raw = p.B1 + (size_t)MT * 3 * D;
  p.hdn3 = take((size_t)(SEQ + CTXL) * 128);
  p.fnorm = take(4 * D);
  p.gg = take((size_t)MT * 64);
  p.bt = take((size_t)MT * 64);
  p.Wgu = takeb((size_t)2 * DFF * D);
  p.Wd = takeb((size_t)D * DFF);
  p.Wm1 = takeb((size_t)GDN_LD * D);
  p.Wm2 = takeb((size_t)D * GDN_V);
  (void)ws_size; (void)n_in; (void)in_sizes; (void)out_size;
  static bool attr_done = false;
  if (!attr_done) { (void)hipFuncSetAttribute((const void*)fwd, hipFuncAttributeMaxDynamicSharedMemorySize, LDS_TOTAL); attr_done = true; }
  (void)hipMemsetAsync(p.bar, 0, XCD_BAR_WORDS * sizeof(unsigned), stream);
  hipLaunchKernelGGL(fwd, dim3(256), dim3(512), LDS_TOTAL, stream, p);
}
```
